# Optimizing an MI355X kernel written in HIP

```python
import math
import jax, jax.numpy as jnp
from jax import lax
import numpy as np

D_MODEL = 1024
BATCH = 2
SEQ = 8192
DEPTH = 2

CTX_LEN = 256
GRID_W = 64
N_HEADS = 8
QK_DIM = 64
V_DIM = 2 * QK_DIM
ATTN_W = N_HEADS * V_DIM
CONV_W = 1024
CONV_K = 3
D_FF = -(-8 * D_MODEL // (3 * 256)) * 256
ROPE_BASE = 10000.0
ROPE_PAIRS_PER_AXIS = QK_DIM // 4
ATTN_SCALE = QK_DIM ** -0.5
Q_BLOCK = 128
EPS = 1e-6
N_MOD = 6

OFF_K = N_HEADS * 2 * QK_DIM
OFF_V = OFF_K + N_HEADS * 2 * QK_DIM
OFF_CX = OFF_V + ATTN_W
OFF_CB = OFF_CX + CONV_W
OFF_CC = OFF_CB + CONV_W
OFF_GA = OFF_CC + CONV_W
OFF_GC = OFF_GA + D_MODEL
N_IN = OFF_GC + D_MODEL
SPLITS = (OFF_K, OFF_V, OFF_CX, OFF_CB, OFF_CC, OFF_GA, OFF_GC)

kernel_name = "hybrid_diffattn_shortconv_dit"


def rms_norm(x, g):
    xf = x.astype(jnp.float32)
    y = xf * lax.rsqrt(jnp.mean(xf * xf, axis=-1, keepdims=True) + EPS)
    return (y * g.astype(jnp.float32)).astype(x.dtype)


def modulate(h, shift, scale):
    return h * (1 + scale) + shift


def axial_rope(n_tokens):
    rows = n_tokens // GRID_W
    row = jnp.repeat(jnp.arange(rows, dtype=jnp.float32), GRID_W)
    col = jnp.tile(jnp.arange(GRID_W, dtype=jnp.float32), rows)
    inv_freq = ROPE_BASE ** (-jnp.arange(ROPE_PAIRS_PER_AXIS, dtype=jnp.float32) / ROPE_PAIRS_PER_AXIS)
    ang = jnp.concatenate([row[:, None] * inv_freq, col[:, None] * inv_freq], axis=-1)
    return jnp.cos(ang), jnp.sin(ang)


def apply_rope(t, cos, sin):
    t1, t2 = jnp.split(t, 2, axis=-1)
    cos = cos.astype(t.dtype)
    sin = sin.astype(t.dtype)
    return jnp.concatenate([t1 * cos - t2 * sin, t2 * cos + t1 * sin], axis=-1)


def split_qk_heads(t, g):
    b, n, _ = t.shape
    t = t.reshape(b, n, N_HEADS, 2, QK_DIM).transpose(0, 2, 3, 1, 4)
    return rms_norm(t, g)


def split_v_heads(v):
    b, n, _ = v.shape
    return v.reshape(b, n, N_HEADS, V_DIM).transpose(0, 2, 1, 3)


def diff_weights(s, lam):
    p = jax.nn.softmax(s.astype(jnp.float32), axis=-1)
    return p[:, :, 0] - lam * p[:, :, 1]


def diff_attn_latent(q, k_all, v_all, lam):
    b, h, _, n, d = q.shape
    nb = n // Q_BLOCK
    qb = q.reshape(b, h, 2, nb, Q_BLOCK, d).transpose(3, 0, 1, 2, 4, 5)

    def one_block(qblk):
        s = jnp.einsum("bhmqd,bhmkd->bhmqk", qblk, k_all) * ATTN_SCALE
        w = diff_weights(s, lam)
        return jnp.einsum("bhqk,bhkd->bhqd", w.astype(v_all.dtype), v_all)

    o = lax.map(one_block, qb)
    return o.transpose(1, 2, 0, 3, 4).reshape(b, h, n, V_DIM)


def diff_attn_ctx(q, k, v, lam):
    s = jnp.einsum("bhmqd,bhmkd->bhmqk", q, k) * ATTN_SCALE
    w = diff_weights(s, lam)
    return jnp.einsum("bhqk,bhkd->bhqd", w.astype(v.dtype), v)


def diff_head_out(o, g, lam_init):
    o = rms_norm(o, g) * (1 - lam_init)
    b, h, n, d = o.shape
    return o.transpose(0, 2, 1, 3).reshape(b, n, h * d)


def short_conv(u, w):
    up = jnp.pad(u, ((0, 0), (1, 1), (0, 0)))
    return up[:, :-2] * w[0] + up[:, 1:-1] * w[1] + up[:, 2:] * w[2]


def merge_branches(attn, cx, cb, cc, ga, gc, conv_w, w_pa, w_pc, w_o):
    y_conv = cb * short_conv(cc * cx, conv_w)
    ya = attn @ w_pa
    yc = y_conv @ w_pc
    return (jax.nn.sigmoid(ga) * ya + jax.nn.sigmoid(gc) * yc) @ w_o


def swiglu(h, wg, wu, wd):
    return (jax.nn.silu(h @ wg) * (h @ wu)) @ wd


def setup_inputs(seed: int = 0) -> dict:
    key = jax.random.key(seed)
    ks = jax.random.split(key, 24)
    f32 = jnp.float32
    nrm = lambda k, shape, s: jax.random.normal(k, shape, f32) * s
    return {
        "x": nrm(ks[0], (BATCH, SEQ, D_MODEL), 1.0),
        "c": nrm(ks[1], (BATCH, D_MODEL), 1.0),
        "ctx": nrm(ks[2], (BATCH, CTX_LEN, D_MODEL), 1.0),
        "c_ctx": nrm(ks[3], (D_MODEL,), 1.0),
        "w_ada": nrm(ks[4], (DEPTH, D_MODEL, N_MOD * D_MODEL), 0.5 * D_MODEL ** -0.5),
        "b_ada": nrm(ks[5], (DEPTH, N_MOD * D_MODEL), 0.02),
        "norm1_g": 1.0 + nrm(ks[6], (DEPTH, D_MODEL), 0.02),
        "norm2_g": 1.0 + nrm(ks[7], (DEPTH, D_MODEL), 0.02),
        "w_in": nrm(ks[8], (DEPTH, D_MODEL, N_IN), D_MODEL ** -0.5),
        "q_norm_g": 1.0 + nrm(ks[9], (DEPTH, QK_DIM), 0.02),
        "k_norm_g": 1.0 + nrm(ks[10], (DEPTH, QK_DIM), 0.02),
        "lambda_q1": nrm(ks[11], (DEPTH, QK_DIM), 0.1),
        "lambda_k1": nrm(ks[12], (DEPTH, QK_DIM), 0.1),
        "lambda_q2": nrm(ks[13], (DEPTH, QK_DIM), 0.1),
        "lambda_k2": nrm(ks[14], (DEPTH, QK_DIM), 0.1),
        "subln_g": 1.0 + nrm(ks[15], (DEPTH, V_DIM), 0.02),
        "conv_w": nrm(ks[16], (DEPTH, CONV_K, CONV_W), CONV_K ** -0.5),
        "w_pa": nrm(ks[17], (DEPTH, ATTN_W, D_MODEL), ATTN_W ** -0.5),
        "w_pc": nrm(ks[18], (DEPTH, CONV_W, D_MODEL), CONV_W ** -0.5),
        "w_o": nrm(ks[19], (DEPTH, D_MODEL, D_MODEL), D_MODEL ** -0.5),
        "w_ffn_gate": nrm(ks[20], (DEPTH, D_MODEL, D_FF), D_MODEL ** -0.5),
        "w_ffn_up": nrm(ks[21], (DEPTH, D_MODEL, D_FF), D_MODEL ** -0.5),
        "w_ffn_down": nrm(ks[22], (DEPTH, D_FF, D_MODEL), D_FF ** -0.5),
    }


def reference(x, c, ctx, c_ctx, w_ada, b_ada, norm1_g, norm2_g, w_in, q_norm_g, k_norm_g,
              lambda_q1, lambda_k1, lambda_q2, lambda_k2, subln_g, conv_w, w_pa, w_pc, w_o,
              w_ffn_gate, w_ffn_up, w_ffn_down):
    n_lat = x.shape[1]
    cos, sin = axial_rope(n_lat)
    for li in range(DEPTH):
        last = li == DEPTH - 1
        lam_init = 0.8 - 0.6 * math.exp(-0.3 * li)
        lam = (jnp.exp(jnp.sum((lambda_q1[li] * lambda_k1[li]).astype(jnp.float32)))
               - jnp.exp(jnp.sum((lambda_q2[li] * lambda_k2[li]).astype(jnp.float32)))
               + lam_init)

        mod = jax.nn.silu(c) @ w_ada[li] + b_ada[li]
        mod_c = jax.nn.silu(c_ctx) @ w_ada[li] + b_ada[li]
        sh1, sc1, g1, sh2, sc2, g2 = [m[:, None, :] for m in jnp.split(mod, N_MOD, axis=-1)]
        csh1, csc1, cg1, csh2, csc2, cg2 = jnp.split(mod_c, N_MOD, axis=-1)

        h = modulate(rms_norm(x, norm1_g[li]), sh1, sc1)
        hc = modulate(rms_norm(ctx, norm1_g[li]), csh1, csc1)
        q, k, v, cx, cb, cc, ga, gc = jnp.split(h @ w_in[li], SPLITS, axis=-1)
        if last:
            kc, vc = jnp.split(hc @ w_in[li][:, OFF_K:OFF_CX], [OFF_V - OFF_K], axis=-1)
        else:
            qc, kc, vc, cxc, cbc, ccc, gac, gcc = jnp.split(hc @ w_in[li], SPLITS, axis=-1)

        kc_h = split_qk_heads(kc, k_norm_g[li])
        vc_h = split_v_heads(vc)
        q_h = apply_rope(split_qk_heads(q, q_norm_g[li]), cos, sin)
        k_h = apply_rope(split_qk_heads(k, k_norm_g[li]), cos, sin)
        k_all = jnp.concatenate([kc_h, k_h], axis=3)
        v_all = jnp.concatenate([vc_h, split_v_heads(v)], axis=2)
        attn = diff_head_out(diff_attn_latent(q_h, k_all, v_all, lam), subln_g[li], lam_init)

        mix = merge_branches(attn, cx, cb, cc, ga, gc, conv_w[li], w_pa[li], w_pc[li], w_o[li])
        x = x + g1 * mix
        hf = modulate(rms_norm(x, norm2_g[li]), sh2, sc2)
        x = x + g2 * swiglu(hf, w_ffn_gate[li], w_ffn_up[li], w_ffn_down[li])

        if not last:
            qc_h = split_qk_heads(qc, q_norm_g[li])
            attn_c = diff_head_out(diff_attn_ctx(qc_h, kc_h, vc_h, lam), subln_g[li], lam_init)
            mix_c = merge_branches(attn_c, cxc, cbc, ccc, gac, gcc, conv_w[li],
                                   w_pa[li], w_pc[li], w_o[li])
            ctx = ctx + cg1 * mix_c
            hfc = modulate(rms_norm(ctx, norm2_g[li]), csh2, csc2)
            ctx = ctx + cg2 * swiglu(hfc, w_ffn_gate[li], w_ffn_up[li], w_ffn_down[li])
    return x
```

```cpp
#include <hip/hip_runtime.h>
#include <hip/hip_bf16.h>
#include <hip/hip_cooperative_groups.h>
#include <cstdio>
#include <cstdint>
namespace cg = cooperative_groups;


#ifndef MK_MULTI
#define MK_MULTI 0
#endif

constexpr int DM = 1024, NBATCH = 2, SEQ = 8192, NCTX = 256, NLAT = NBATCH * SEQ, MT = NLAT + NBATCH * NCTX;
constexpr int DFF = 2816, NIN = 8192;
constexpr float EPS = 1e-6f;
constexpr size_t MiB = 1u << 20;
constexpr size_t SEC = (size_t)MT * DM * 2;
constexpr size_t SECE = (size_t)MT * DM;
constexpr size_t WS_CTL = 0, WS_MOD = 65536, WS_ROPE = 1 * MiB, WS_CTXX = 3 * MiB, WS_W = 5 * MiB;
constexpr size_t W_IN = WS_W, W_PA = W_IN + 16 * MiB, W_PC = W_PA + 2 * MiB, W_O = W_PC + 2 * MiB, W_GU = W_O + 2 * MiB, W_D = W_GU + 11 * MiB;
constexpr size_t WS_H = 44 * MiB, WS_ATT = WS_H + SEC, WS_R = WS_ATT + SEC, WS_END = WS_R + 4 * SEC;
constexpr size_t WS_PART = WS_END, WS_END2 = WS_PART + (size_t)4 * 512 * DM * 4;
static_assert((size_t)MT * DFF * 2 <= 4 * SEC, "FFN hidden fits the mixer region");
constexpr int LDS_BYTES = 147456;
namespace pg8 {
#define PG8_LAS __attribute__((address_space(3)))
typedef unsigned short bf16_t;
typedef short bf16x8 __attribute__((ext_vector_type(8)));
typedef float f32x4 __attribute__((ext_vector_type(4)));
typedef unsigned u32x4 __attribute__((ext_vector_type(4)));
constexpr int BM = 256, BK = 64, HALF = 128, HTB = HALF * BK * 2  , STAGE_BYTES = 8 * HTB, NXCD = 8, WGM = 16;

__host__ __device__ __forceinline__ int lds_byte(int r, int c) { const int st = (r >> 4) * 2 + (c >> 5), rr = r & 15, cc = c & 31, ob = rr * 64 + cc * 2; return st * 1024 + (ob ^ (((ob >> 9) & 1) << 5)); }
__host__ __device__ __forceinline__ void stage_rc(int b, int& R, int& C) { const int st = b / 1024, sb = b % 1024, swz = sb ^ (((sb >> 9) & 1) << 5); R = (st >> 1) * 16 + swz / 64; C = (st & 1) * 32 + (swz % 64) / 2; }
__host__ __device__ __forceinline__ int perm32(int rho) { const int n = rho >> 4, i = rho & 15; return 8 * (i >> 2) + 4 * n + (i & 3); }

struct Unit { int pm, pn, kb, nkt, kc; };
struct Gemm { const bf16_t* A; const bf16_t* Bt; int M, N, K; };

struct StaticOrder {
    int nM, nN, nwg, G, c, nkt0;
    __host__ __device__ void init(int M, int N, int G_, int c_, int K_ = 1024) { nM = M / BM; nN = N / BM; nwg = nM * nN; G = G_; c = c_; nkt0 = K_ / BK; }
    __host__ __device__ bool next(int i, Unit& u) const {
        const long L = (long)i * G + c; if (L >= nwg) return false;
        int wgid = (int)L; { const int q = nwg / NXCD, r = nwg % NXCD, xcd = wgid % NXCD, off = wgid / NXCD; wgid = (xcd < r ? xcd * (q + 1) : r * (q + 1) + (xcd - r) * q) + off; }
        const int nig = WGM * nN, gid = wgid / nig, fm = gid * WGM, gsz = (nM - fm) < WGM ? (nM - fm) : WGM;
        u.pm = fm + ((wgid % nig) % gsz); u.pn = (wgid % nig) / gsz; u.kb = 0; u.nkt = nkt0; u.kc = 0; return true;
    }
    __device__ __forceinline__ void a_ready(const Unit&) const {}
    __device__ __forceinline__ void done(const Unit&) const {}
};
struct SplitOrder {
    StaticOrder base; int nl, G, c, q, r, ns, nt;
    __device__ void init(int Mlat, int N, int G_, int c_, int K_, int ns_ = 4) { base.init(Mlat, N, G_, c_, K_); G = G_; c = c_; ns = ns_; nl = c_ < base.nwg ? (base.nwg - c_ + G_ - 1) / G_ : 0;
        nt = K_ / BK; q = (nt / 4) & ~1; r = (nt - 4 * q) / 2; }
    __device__ bool next(int i, Unit& u) const {
        if (i < nl) return base.next(i, u);
        const int e = (i - nl) * G + c; if (e >= 8 * ns) return false;
        if (ns == 1) { u.pm = 64 + (e >> 2); u.pn = e & 3; u.kb = 0; u.nkt = nt; u.kc = 0; return true; }
        const int t = e >> 2, ch = e & 3; u.pm = 64 + (t >> 2); u.pn = t & 3; u.kb = ch * q + 2 * (ch < r ? ch : r); u.nkt = q + (ch < r ? 2 : 0); u.kc = ch; return true; }
    __device__ __forceinline__ void a_ready(const Unit&) const {}
    __device__ __forceinline__ void done(const Unit&) const {}
};
struct OneUnit {
    int pm, pn, nkt, valid;
    __device__ bool next(int i, Unit& u) const { if (i != 0 || !valid) return false; u.pm = pm; u.pn = pn; u.kb = 0; u.nkt = nkt; u.kc = 0; return true; }
    __device__ __forceinline__ void a_ready(const Unit&) const {}
    __device__ __forceinline__ void done(const Unit&) const {}
};
__device__ __forceinline__ unsigned cvt_pk_bf16(float lo, float hi) { unsigned r; asm volatile("v_cvt_pk_bf16_f32 %0, %1, %2" : "=v"(r) : "v"(lo), "v"(hi)); return r; }
typedef float f32x2 __attribute__((ext_vector_type(2)));

typedef unsigned u32x4 __attribute__((ext_vector_type(4)));
__device__ __forceinline__ u32x4 pack8(const f32x4 a, const f32x4 b) { u32x4 w; w.x = cvt_pk_bf16(a[0], a[1]); w.y = cvt_pk_bf16(a[2], a[3]); w.z = cvt_pk_bf16(b[0], b[1]); w.w = cvt_pk_bf16(b[2], b[3]); return w; }
__device__ __forceinline__ float bf_lo(unsigned w) { return __uint_as_float(w << 16); }
__device__ __forceinline__ float bf_hi(unsigned w) { return __uint_as_float(w & 0xffff0000u); }
__device__ __forceinline__ void unpack8(const u32x4 w, f32x4& a, f32x4& b) { a = (f32x4){bf_lo(w.x), bf_hi(w.x), bf_lo(w.y), bf_hi(w.y)}; b = (f32x4){bf_lo(w.z), bf_hi(w.z), bf_lo(w.w), bf_hi(w.w)}; }
__device__ __forceinline__ float sigm(float x) { return __builtin_amdgcn_rcpf(1.0f + __builtin_amdgcn_exp2f(x * -1.4426950408889634f)); }
__device__ __forceinline__ f32x4 sigm4(const f32x4 x) { return (f32x4){sigm(x[0]), sigm(x[1]), sigm(x[2]), sigm(x[3])}; }

struct EpiQKV {
    static constexpr bool PERM = true, AFTER_DRAIN = false;
    bf16_t* R; const float* qg; const float* kg; const float* rope;
    __device__ __forceinline__ void operator()(const f32x4 (&acc)[2][2][4][2], const Unit& u, int wr, int wc, int fr, int fq) const {
        const int sec = u.pn >> 2, ct = u.pn & 3;
        const int row0 = u.pm * BM + wr * 64 + fr;
        bf16_t* base = R + (size_t)sec * SECE;
        if (sec == 2) {
            const int col0 = ct * 256 + wc * 32 + 8 * fq;
#pragma unroll
            for (int ai = 0; ai < 2; ++ai)
#pragma unroll
                for (int m = 0; m < 4; ++m) { bf16_t* rowp = base + (size_t)(row0 + ai * HALF + m * 16) * DM + col0;
#pragma unroll
                    for (int bj = 0; bj < 2; ++bj) *(u32x4*)(rowp + bj * HALF) = pack8(acc[ai][bj][m][0], acc[ai][bj][m][1]); }
        } else {
            const float* gp = (sec == 0 ? qg : kg) + 8 * fq;
            const float qs = sec == 0 ? 0.18033688011112042f : 1.0f;
            f32x4 g[2][2];
#pragma unroll
            for (int bj = 0; bj < 2; ++bj)
#pragma unroll
                for (int n = 0; n < 2; ++n) g[bj][n] = *(const f32x4*)(gp + bj * 32 + 4 * n);
            const int col0 = ct * 256 + wc * 64 + 8 * fq;
#pragma unroll
            for (int ai = 0; ai < 2; ++ai)
#pragma unroll
                for (int m = 0; m < 4; ++m) {
                    const int row = row0 + ai * HALF + m * 16;
                    float ss = 0.f;
#pragma unroll
                    for (int bj = 0; bj < 2; ++bj)
#pragma unroll
                        for (int n = 0; n < 2; ++n) { const f32x4 x = acc[ai][bj][m][n]; ss += (x[0] * x[0] + x[1] * x[1]) + (x[2] * x[2] + x[3] * x[3]); }
                    ss += __shfl_xor(ss, 16); ss += __shfl_xor(ss, 32);
                    const float rstd = rsqrtf(ss * (1.0f / 64.0f) + EPS);
                    f32x4 y[2][2];
#pragma unroll
                    for (int bj = 0; bj < 2; ++bj)
#pragma unroll
                        for (int n = 0; n < 2; ++n) y[bj][n] = acc[ai][bj][m][n] * (rstd * qs) * g[bj][n];
                    if (row < NLAT) {
                        const f32x4* rp = (const f32x4*)(rope + ((size_t)(row & (SEQ - 1)) * 32 + 8 * fq) * 2);
#pragma unroll
                        for (int n = 0; n < 2; ++n) {
                            const f32x4 a = rp[2 * n], b = rp[2 * n + 1];
                            const f32x4 t1 = y[0][n], t2 = y[1][n];
                            y[0][n] = (f32x4){t1[0] * a[0] - t2[0] * a[1], t1[1] * a[2] - t2[1] * a[3], t1[2] * b[0] - t2[2] * b[1], t1[3] * b[2] - t2[3] * b[3]};
                            y[1][n] = (f32x4){t2[0] * a[0] + t1[0] * a[1], t2[1] * a[2] + t1[1] * a[3], t2[2] * b[0] + t1[2] * b[1], t2[3] * b[2] + t1[3] * b[3]};
                        }
                    }
                    bf16_t* rowp = base + (size_t)row * DM + col0;
#pragma unroll
                    for (int bj = 0; bj < 2; ++bj) *(u32x4*)(rowp + bj * 32) = pack8(y[bj][0], y[bj][1]);
                }
        }
    }
};

struct EpiG2 {
    static constexpr bool PERM = true, AFTER_DRAIN = false;
    bf16_t* R;
    __device__ __forceinline__ void operator()(const f32x4 (&acc)[2][2][4][2], const Unit& u, int wr, int wc, int fr, int fq) const {
        const int row0 = u.pm * BM + wr * 64 + fr;
        if (u.pn < 8) {
            const int col0 = u.pn * 128 + wc * 32 + 8 * fq;
#pragma unroll
            for (int ai = 0; ai < 2; ++ai)
#pragma unroll
                for (int m = 0; m < 4; ++m)
                    *(u32x4*)(R + (size_t)(row0 + ai * HALF + m * 16) * DM + col0) = pack8(acc[ai][0][m][0] * acc[ai][1][m][0], acc[ai][0][m][1] * acc[ai][1][m][1]);
        } else {
            const int sec = (u.pn - 8) >> 2, ct = (u.pn - 8) & 3;
            bf16_t* base = R + (size_t)(sec + 1) * SECE;
            const int col0 = ct * 256 + wc * 32 + 8 * fq;
#pragma unroll
            for (int ai = 0; ai < 2; ++ai)
#pragma unroll
                for (int m = 0; m < 4; ++m) { bf16_t* rowp = base + (size_t)(row0 + ai * HALF + m * 16) * DM + col0;
#pragma unroll
                    for (int bj = 0; bj < 2; ++bj) {
                        f32x4 v0 = acc[ai][bj][m][0], v1 = acc[ai][bj][m][1];
                        if (sec > 0) { v0 = sigm4(v0); v1 = sigm4(v1); }
                        *(u32x4*)(rowp + bj * HALF) = pack8(v0, v1); } }
        }
    }
};

struct EpiM1 {
    static constexpr bool PERM = true, AFTER_DRAIN = false;
    bf16_t* GA;
    __device__ __forceinline__ void operator()(const f32x4 (&acc)[2][2][4][2], const Unit& u, int wr, int wc, int fr, int fq) const {
        const int row0 = u.pm * BM + wr * 64 + fr, col0 = u.pn * 256 + wc * 32 + 8 * fq;
#pragma unroll
        for (int ai = 0; ai < 2; ++ai)
#pragma unroll
            for (int m = 0; m < 4; ++m) { bf16_t* rowp = GA + (size_t)(row0 + ai * HALF + m * 16) * DM + col0;
#pragma unroll
                for (int bj = 0; bj < 2; ++bj) { f32x4 s0, s1; unpack8(*(const u32x4*)(rowp + bj * HALF), s0, s1);
                    *(u32x4*)(rowp + bj * HALF) = pack8(s0 * acc[ai][bj][m][0], s1 * acc[ai][bj][m][1]); } }
    }
};
struct EpiM2 {
    static constexpr bool PERM = true, AFTER_DRAIN = false;
    const bf16_t* T; bf16_t* GC;
    __device__ __forceinline__ void operator()(const f32x4 (&acc)[2][2][4][2], const Unit& u, int wr, int wc, int fr, int fq) const {
        const int row0 = u.pm * BM + wr * 64 + fr, col0 = u.pn * 256 + wc * 32 + 8 * fq;
#pragma unroll
        for (int ai = 0; ai < 2; ++ai)
#pragma unroll
            for (int m = 0; m < 4; ++m) { const size_t off = (size_t)(row0 + ai * HALF + m * 16) * DM + col0;
#pragma unroll
                for (int bj = 0; bj < 2; ++bj) { f32x4 s0, s1, t0, t1; unpack8(*(const u32x4*)(GC + off + bj * HALF), s0, s1); unpack8(*(const u32x4*)(T + off + bj * HALF), t0, t1);
                    *(u32x4*)(GC + off + bj * HALF) = pack8(t0 + s0 * acc[ai][bj][m][0], t1 + s1 * acc[ai][bj][m][1]); } }
    }
};
struct EpiRes {
    static constexpr bool PERM = false, AFTER_DRAIN = false;
    const float* inL; const float* inC; float* outL; float* outC; const float* gate;
    float* part;
    __device__ __forceinline__ void operator()(const f32x4 (&acc)[2][2][4][2], const Unit& u, int wr, int wc, int fr, int fq) const {
        const int s = u.pm < 32 ? 0 : (u.pm < 64 ? 1 : 2);
        const bool isc = u.pm >= 64;
        if (isc && part) {
            float* pb = part + (size_t)u.kc * 512 * DM; const int prow0 = (u.pm - 64) * BM + wr * 64 + fr, pcol0 = u.pn * 256 + wc * 32 + 4 * fq;
#pragma unroll
            for (int ai = 0; ai < 2; ++ai)
#pragma unroll
                for (int m = 0; m < 4; ++m) { const size_t off = (size_t)(prow0 + ai * HALF + m * 16) * DM + pcol0;
#pragma unroll
                    for (int bj = 0; bj < 2; ++bj)
#pragma unroll
                        for (int n = 0; n < 2; ++n) *(f32x4*)(pb + off + bj * HALF + n * 16) = acc[ai][bj][m][n]; }
            return;
        }
        const float* ib = isc ? inC : inL; float* ob = isc ? outC : outL;
        const int row0 = (isc ? (u.pm - 64) : u.pm) * BM + wr * 64 + fr, col0 = u.pn * 256 + wc * 32 + 4 * fq;
        f32x4 gv[2][2];
#pragma unroll
        for (int bj = 0; bj < 2; ++bj)
#pragma unroll
            for (int n = 0; n < 2; ++n) gv[bj][n] = *(const f32x4*)(gate + s * 6144 + col0 + bj * HALF + n * 16);
#pragma unroll
        for (int ai = 0; ai < 2; ++ai)
#pragma unroll
            for (int m = 0; m < 4; ++m) { const size_t off = (size_t)(row0 + ai * HALF + m * 16) * DM + col0;
#pragma unroll
                for (int bj = 0; bj < 2; ++bj)
#pragma unroll
                    for (int n = 0; n < 2; ++n) { const f32x4 bs = *(const f32x4*)(ib + off + bj * HALF + n * 16);
                        *(f32x4*)(ob + off + bj * HALF + n * 16) = bs + gv[bj][n] * acc[ai][bj][m][n]; }
                if (m == 3) asm volatile("" ::: "memory"); }
    }
};
struct EpiGU {
    static constexpr bool PERM = true, AFTER_DRAIN = false;
    bf16_t* F;
    __device__ __forceinline__ void operator()(const f32x4 (&acc)[2][2][4][2], const Unit& u, int wr, int wc, int fr, int fq) const {
        const int row0 = u.pm * BM + wr * 64 + fr, col0 = u.pn * 128 + wc * 32 + 8 * fq;
#pragma unroll
        for (int ai = 0; ai < 2; ++ai)
#pragma unroll
            for (int m = 0; m < 4; ++m) {
                const f32x4 g0 = acc[ai][0][m][0], g1 = acc[ai][0][m][1];
                const f32x4 v0 = g0 * sigm4(g0) * acc[ai][1][m][0], v1 = g1 * sigm4(g1) * acc[ai][1][m][1];
                *(u32x4*)(F + (size_t)(row0 + ai * HALF + m * 16) * DFF + col0) = pack8(v0, v1); }
    }
};
template <class Epi, class Sched, bool ALIGN_EPI = false, bool SP2 = false>
__device__ __forceinline__ void gemm_phase(PG8_LAS unsigned char* lds, const Gemm g, const Sched& S, const Epi& E) {
    const int tid = threadIdx.x, wid = __builtin_amdgcn_readfirstlane(tid >> 6), lane = tid & 63, wr = wid >> 2, wc = wid & 3, fr = lane & 15, fq = lane >> 4;
    const int K = g.K;
    unsigned voffA[2], voffB[2];
#pragma unroll
    for (int i = 0; i < 2; ++i) { int R, C; stage_rc(tid * 16 + i * 8192, R, C); const int Rb = Epi::PERM ? ((R & ~31) + perm32(R & 31)) : R;
        voffA[i] = (unsigned)(R * K + C) * 2u; voffB[i] = (unsigned)(Rb * K + C) * 2u; }
    const size_t kstep = (size_t)(BK * 2);
    const size_t hstep = (size_t)HALF * K * 2;
    const size_t tstep = 2 * hstep;
    const unsigned ldsw = (unsigned)wid * 1024u;
    const int aoff = lds_byte(wr * 64 + fr, fq * 8), boff = lds_byte(wc * 32 + fr, fq * 8);
#define PG8_SA(b, h) (((b) * 2 + (h)) * HTB)
#define PG8_SB(b, h) ((4 + (b) * 2 + (h)) * HTB)
#define PG8_STAGE(bufoff, gbase, voff) do { _Pragma("unroll") for (int _i = 0; _i < 2; ++_i) \
        __builtin_amdgcn_global_load_lds((const unsigned*)((const char*)(gbase) + (voff)[_i]), (PG8_LAS unsigned*)(lds + (bufoff) + ldsw + _i * 8192), 16, 0, 0); } while (0)
#define PG8_LDA(dst, b, h) do { _Pragma("unroll") for (int m = 0; m < 4; ++m) _Pragma("unroll") for (int k = 0; k < 2; ++k) dst[m][k] = *(const PG8_LAS bf16x8*)(lds + PG8_SA(b, h) + aoff + m * 2048 + k * 1024); } while (0)
#define PG8_LDB(dst, b, h) do { _Pragma("unroll") for (int n = 0; n < 2; ++n) _Pragma("unroll") for (int k = 0; k < 2; ++k) dst[n][k] = *(const PG8_LAS bf16x8*)(lds + PG8_SB(b, h) + boff + n * 2048 + k * 1024); } while (0)
#define PG8_MMA(ai, bj, At, Bt) do { __builtin_amdgcn_s_setprio(1); _Pragma("unroll") for (int m = 0; m < 4; ++m) _Pragma("unroll") for (int n = 0; n < 2; ++n) _Pragma("unroll") for (int k = 0; k < 2; ++k) \
        acc[ai][bj][m][n] = __builtin_amdgcn_mfma_f32_16x16x32_bf16(Bt[n][k], At[m][k], acc[ai][bj][m][n], 0, 0, 0); __builtin_amdgcn_s_setprio(0); } while (0)
#define PG8_WAIT_V(n) asm volatile("s_waitcnt vmcnt(" #n ")" ::: "memory")
#define PG8_WAIT_L(n) asm volatile("s_waitcnt lgkmcnt(" #n ")" ::: "memory")
#define PG8_BAR __builtin_amdgcn_s_barrier()
#define PG8_SCHED __builtin_amdgcn_sched_barrier(0)
    Unit cur, nxt; int ui = 0;
    if (!S.next(0, cur)) return;
    f32x4 acc[2][2][4][2];
#pragma unroll
    for (int a = 0; a < 2; ++a)
#pragma unroll
        for (int b = 0; b < 2; ++b)
#pragma unroll
            for (int m = 0; m < 4; ++m)
#pragma unroll
                for (int n = 0; n < 2; ++n) acc[a][b][m][n] = (f32x4){0.f, 0.f, 0.f, 0.f};
    bf16x8 At[4][2], B0[2][2], B1[2][2];
    const char* cA = (const char*)g.A + (size_t)cur.pm * tstep + (size_t)cur.kb * kstep; const char* cB = (const char*)g.Bt + (size_t)cur.pn * tstep + (size_t)cur.kb * kstep;
    S.a_ready(cur);
    if constexpr (SP2) {
        PG8_STAGE(PG8_SB(0, 0), cB, voffB); PG8_STAGE(PG8_SB(0, 1), cB + hstep, voffB); PG8_STAGE(PG8_SA(0, 0), cA, voffA); PG8_STAGE(PG8_SA(0, 1), cA + hstep, voffA);
        if (wr == 1) PG8_BAR;
        PG8_WAIT_V(2); PG8_BAR;
        PG8_STAGE(PG8_SB(1, 0), cB + kstep, voffB); PG8_STAGE(PG8_SA(1, 0), cA + kstep, voffA); PG8_STAGE(PG8_SB(1, 1), cB + hstep + kstep, voffB);
        PG8_WAIT_V(6); PG8_BAR;
    } else {
        PG8_STAGE(PG8_SB(0, 0), cB, voffB); PG8_STAGE(PG8_SA(0, 0), cA, voffA); PG8_STAGE(PG8_SB(0, 1), cB + hstep, voffB); PG8_STAGE(PG8_SA(0, 1), cA + hstep, voffA);
        if (wr == 1) PG8_BAR;
        PG8_WAIT_V(4); PG8_BAR;
        PG8_STAGE(PG8_SB(1, 0), cB + kstep, voffB); PG8_STAGE(PG8_SA(1, 0), cA + kstep, voffA); PG8_STAGE(PG8_SB(1, 1), cB + hstep + kstep, voffB);
        PG8_WAIT_V(6); PG8_BAR;
    }
    for (;;) {
        const bool has_next = S.next(ui + 1, nxt);
        const char* nA = has_next ? (const char*)g.A + (size_t)nxt.pm * tstep + (size_t)nxt.kb * kstep : cA; const char* nB = has_next ? (const char*)g.Bt + (size_t)nxt.pn * tstep + (size_t)nxt.kb * kstep : cB;
        const int nt = cur.nkt;
        for (int t = 0; t < nt; t += 2) {
            const bool last = (t == nt - 2);
            const char* a1 = cA + (size_t)(t + 1) * kstep;
            const char* a2 = last ? nA : cA + (size_t)(t + 2) * kstep; const char* b2 = last ? nB : cB + (size_t)(t + 2) * kstep;
            const char* a3 = a2 + kstep; const char* b3 = b2 + kstep;
            if (last && has_next) S.a_ready(nxt);
            if constexpr (SP2) {
            PG8_LDB(B0, 0, 0); PG8_LDB(B1, 0, 1); PG8_SCHED; PG8_LDA(At, 0, 0); PG8_STAGE(PG8_SA(1, 1), a1 + hstep, voffA);
            PG8_WAIT_V(8); PG8_WAIT_L(0); PG8_BAR; PG8_MMA(0, 0, At, B0); PG8_MMA(0, 1, At, B1); PG8_BAR; PG8_SCHED;
            PG8_LDA(At, 0, 1); PG8_STAGE(PG8_SB(0, 0), b2, voffB); PG8_STAGE(PG8_SB(0, 1), b2 + hstep, voffB); PG8_STAGE(PG8_SA(0, 0), a2, voffA);
            PG8_WAIT_V(8); PG8_WAIT_L(0); PG8_BAR; PG8_MMA(1, 0, At, B0); PG8_MMA(1, 1, At, B1); PG8_BAR; PG8_SCHED;
            PG8_LDB(B0, 1, 0); PG8_LDB(B1, 1, 1); PG8_SCHED; PG8_LDA(At, 1, 0); PG8_STAGE(PG8_SA(0, 1), a2 + hstep, voffA);
            PG8_WAIT_V(8); PG8_WAIT_L(0); PG8_BAR; PG8_MMA(0, 0, At, B0); PG8_MMA(0, 1, At, B1); PG8_BAR; PG8_SCHED;
            PG8_LDA(At, 1, 1); PG8_STAGE(PG8_SB(1, 0), b3, voffB); PG8_STAGE(PG8_SB(1, 1), b3 + hstep, voffB); PG8_STAGE(PG8_SA(1, 0), a3, voffA);
            PG8_WAIT_V(8); PG8_WAIT_L(0); PG8_BAR; PG8_MMA(1, 0, At, B0); PG8_MMA(1, 1, At, B1); PG8_BAR; PG8_SCHED;
            } else {
            PG8_LDB(B0, 0, 0); PG8_SCHED; PG8_LDA(At, 0, 0); PG8_STAGE(PG8_SA(1, 1), a1 + hstep, voffA);
            PG8_WAIT_L(8); PG8_BAR; PG8_WAIT_L(0); PG8_MMA(0, 0, At, B0); PG8_BAR; PG8_SCHED;
            PG8_LDB(B1, 0, 1); PG8_STAGE(PG8_SB(0, 0), b2, voffB);
            PG8_BAR; PG8_WAIT_L(0); PG8_MMA(0, 1, At, B1); PG8_BAR;
            PG8_LDA(At, 0, 1); PG8_STAGE(PG8_SA(0, 0), a2, voffA);
            PG8_BAR; PG8_WAIT_L(0); PG8_MMA(1, 0, At, B0); PG8_BAR; PG8_SCHED;
            PG8_STAGE(PG8_SB(0, 1), b2 + hstep, voffB);
            PG8_WAIT_V(6); PG8_BAR; PG8_MMA(1, 1, At, B1); PG8_BAR;
            PG8_LDB(B0, 1, 0); PG8_SCHED; PG8_LDA(At, 1, 0); PG8_STAGE(PG8_SA(0, 1), a2 + hstep, voffA);
            PG8_WAIT_L(8); PG8_BAR; PG8_WAIT_L(0); PG8_MMA(0, 0, At, B0); PG8_BAR; PG8_SCHED;
            PG8_LDB(B1, 1, 1); PG8_STAGE(PG8_SB(1, 0), b3, voffB);
            PG8_BAR; PG8_WAIT_L(0); PG8_MMA(0, 1, At, B1); PG8_BAR;
            PG8_LDA(At, 1, 1); PG8_STAGE(PG8_SA(1, 0), a3, voffA);
            PG8_BAR; PG8_WAIT_L(0); PG8_MMA(1, 0, At, B0); PG8_BAR; PG8_SCHED;
            PG8_STAGE(PG8_SB(1, 1), b3 + hstep, voffB);
            PG8_WAIT_V(6); PG8_BAR; PG8_MMA(1, 1, At, B1); PG8_BAR;
            }
        }
        if constexpr (ALIGN_EPI) { if (wr == 0) PG8_BAR; }
        if constexpr (!Epi::AFTER_DRAIN) { E(acc, cur, wr, wc, fr, fq); S.done(cur); }
        if (!has_next) break;
#pragma unroll
        for (int a = 0; a < 2; ++a)
#pragma unroll
            for (int b = 0; b < 2; ++b)
#pragma unroll
                for (int m = 0; m < 4; ++m)
#pragma unroll
                    for (int n = 0; n < 2; ++n) acc[a][b][m][n] = (f32x4){0.f, 0.f, 0.f, 0.f};
        cur = nxt; cA = nA; cB = nB; ++ui;
        if constexpr (ALIGN_EPI) { if (wr == 1) PG8_BAR; }
    }
    PG8_WAIT_V(0);
    if constexpr (!ALIGN_EPI) { if (wr == 0) PG8_BAR; }
    PG8_BAR;
    if constexpr (Epi::AFTER_DRAIN) { E.fused(acc, cur, wr, wc, fr, fq, lds, wid, lane); S.done(cur); }
#undef PG8_SA
#undef PG8_SB
#undef PG8_STAGE
#undef PG8_LDA
#undef PG8_LDB
#undef PG8_MMA
#undef PG8_WAIT_V
#undef PG8_WAIT_L
#undef PG8_BAR
#undef PG8_SCHED
}
}

namespace att {
using bf16 = __hip_bfloat16;
constexpr int NW = 8, QBLK = 32, KVBLK = 64, LDK = 1024;
constexpr float SCALE = 0.125f;
constexpr float THR = 8.f;
constexpr size_t SHM_V = KVBLK * 128 * 2, SHM_K = KVBLK * 128 * 2;
using bf16x8 = __attribute__((ext_vector_type(8))) short;
using s16x4  = __attribute__((ext_vector_type(4))) short;
using f32x16 = __attribute__((ext_vector_type(16))) float;
using f32x8  = __attribute__((ext_vector_type(8))) float;
using u32x4  = __attribute__((ext_vector_type(4))) unsigned;
#define KSWZ(row, colB) ((row) * 256 + ((colB) ^ (((row) & 7) << 4)))
#define SBAR() __builtin_amdgcn_sched_barrier(0)
__device__ __forceinline__ int crow(int r, int hi) { return (r & 3) + 8 * (r >> 2) + 4 * hi; }
__device__ __forceinline__ unsigned cvtpk(float lo, float hi) {
  unsigned r; asm volatile("v_cvt_pk_bf16_f32 %0, %1, %2" : "=v"(r) : "v"(lo), "v"(hi)); return r;
}
template <typename TIn> struct Stage;
template <> struct Stage<bf16>  { using T = bf16x8;
  __device__ static __forceinline__ T ld8(const bf16* p) { return *reinterpret_cast<const bf16x8*>(p); }
  __device__ static __forceinline__ bf16x8 tobf(T x) { return x; } };
template <> struct Stage<float> { using T = f32x8;
  __device__ static __forceinline__ T ld8(const float* p) { return *reinterpret_cast<const f32x8*>(p); }
  __device__ static __forceinline__ bf16x8 tobf(T x) {
    u32x4 w = {cvtpk(x[0], x[1]), cvtpk(x[2], x[3]), cvtpk(x[4], x[5]), cvtpk(x[6], x[7])}; return *reinterpret_cast<bf16x8*>(&w); } };

__device__ __forceinline__ void partialSM(f32x16& p0) {
  for (int r = 0; r < 16; ++r) p0[r] = __builtin_amdgcn_exp2f(p0[r]);
}
__device__ __forceinline__ void finishSM(f32x16& p0, f32x16& p1, float& l_reg, bf16x8& pa0, bf16x8& pa1, bf16x8& pa2, bf16x8& pa3) {
  for (int r = 0; r < 16; ++r) p1[r] = __builtin_amdgcn_exp2f(p1[r]);
  float ps = 0; for (int r = 0; r < 16; ++r) ps += p0[r]; for (int r = 0; r < 16; ++r) ps += p1[r];
  l_reg += ps;
#define PK4(P, BASE, OUT) do { unsigned a0 = cvtpk(P[BASE + 0], P[BASE + 1]), a1 = cvtpk(P[BASE + 2], P[BASE + 3]);   \
    unsigned b0 = cvtpk(P[BASE + 4], P[BASE + 5]), b1 = cvtpk(P[BASE + 6], P[BASE + 7]);                              \
    auto r0 = __builtin_amdgcn_permlane32_swap(a0, b0, false, false); auto r1 = __builtin_amdgcn_permlane32_swap(a1, b1, false, false); \
    u32x4 w = {r0[0], r1[0], r0[1], r1[1]}; OUT = *reinterpret_cast<bf16x8*>(&w); } while (0)
  PK4(p0, 0, pa0); PK4(p0, 8, pa1); PK4(p1, 0, pa2); PK4(p1, 8, pa3);
#undef PK4
}
__device__ __forceinline__ void qkt(f32x16& p0, f32x16& p1, const bf16* Ks, const bf16x8* qr, int r32, int hi) {
  p0 = f32x16{}; p1 = f32x16{};
  for (int d0 = 0; d0 < 8; ++d0) { int cb = (d0 * 16 + hi * 8) * 2;
    bf16x8 b0 = *reinterpret_cast<const bf16x8*>((const char*)Ks + KSWZ(r32, cb));
    bf16x8 b1 = *reinterpret_cast<const bf16x8*>((const char*)Ks + KSWZ(32 + r32, cb));
    p0 = __builtin_amdgcn_mfma_f32_32x32x16_bf16(b0, qr[d0], p0, 0, 0, 0);
    p1 = __builtin_amdgcn_mfma_f32_32x32x16_bf16(b1, qr[d0], p1, 0, 0, 0); }
}
__device__ __forceinline__ int v_st(int k, int c) { const int kk = (k & ~0xC) | ((k & 4) << 1) | ((k & 8) >> 1); return ((kk >> 3) * 4 + (c >> 5)) * 512 + ((kk & 7) * 32 + (c & 31)) * 2; }
__device__ __forceinline__ int v_rd_base(int lane) { return ((lane & 3) << 3) | (((lane >> 2) & 3) << 6) | (((lane >> 4) & 1) << 5) | (((lane >> 5) & 1) << 8); }
constexpr int v_rd_off(int d0, int ks, int half) { return d0 * 512 + ks * 4096 + half * 2048; }
template <int OFF> __device__ __forceinline__ s16x4 tr_read(int vb) {
  s16x4 r; asm volatile("ds_read_b64_tr_b16 %0, %1 offset:%2" : "=&v"(r) : "v"(vb), "i"(OFF) : "memory"); return r;
}
template <int D0> __device__ __forceinline__ void pv_one(f32x16& od, int vb, bf16x8 pa0, bf16x8 pa1, bf16x8 pa2, bf16x8 pa3) {
  const s16x4 l0 = tr_read<v_rd_off(D0, 0, 0)>(vb), h0 = tr_read<v_rd_off(D0, 0, 1)>(vb), l1 = tr_read<v_rd_off(D0, 1, 0)>(vb), h1 = tr_read<v_rd_off(D0, 1, 1)>(vb);
  const s16x4 l2 = tr_read<v_rd_off(D0, 2, 0)>(vb), h2 = tr_read<v_rd_off(D0, 2, 1)>(vb), l3 = tr_read<v_rd_off(D0, 3, 0)>(vb), h3 = tr_read<v_rd_off(D0, 3, 1)>(vb);
  asm volatile("s_waitcnt lgkmcnt(0)" ::: "memory"); SBAR();
#define PK(L, H) (bf16x8){L[0], L[1], L[2], L[3], H[0], H[1], H[2], H[3]}
  od = __builtin_amdgcn_mfma_f32_32x32x16_bf16(pa0, PK(l0, h0), od, 0, 0, 0);
  od = __builtin_amdgcn_mfma_f32_32x32x16_bf16(pa1, PK(l1, h1), od, 0, 0, 0);
  od = __builtin_amdgcn_mfma_f32_32x32x16_bf16(pa2, PK(l2, h2), od, 0, 0, 0);
  od = __builtin_amdgcn_mfma_f32_32x32x16_bf16(pa3, PK(l3, h3), od, 0, 0, 0);
#undef PK
}
__device__ __forceinline__ void pv_d0(f32x16* o, int vb, bf16x8 pa0, bf16x8 pa1, bf16x8 pa2, bf16x8 pa3) {
  pv_one<0>(o[0], vb, pa0, pa1, pa2, pa3); pv_one<1>(o[1], vb, pa0, pa1, pa2, pa3); pv_one<2>(o[2], vb, pa0, pa1, pa2, pa3); pv_one<3>(o[3], vb, pa0, pa1, pa2, pa3);
}

__device__ __forceinline__ void qkt64(f32x16& p0, f32x16& p1, const char* Ks, const bf16x8* qr, int r32, int hi, int cbase) {
  p0 = f32x16{}; p1 = f32x16{};
#pragma unroll
  for (int d0 = 0; d0 < 4; ++d0) { int cb = (cbase + d0 * 16 + hi * 8) * 2;
    bf16x8 b0 = *reinterpret_cast<const bf16x8*>(Ks + KSWZ(r32, cb));
    bf16x8 b1 = *reinterpret_cast<const bf16x8*>(Ks + KSWZ(32 + r32, cb));
    p0 = __builtin_amdgcn_mfma_f32_32x32x16_bf16(b0, qr[d0], p0, 0, 0, 0);
    p1 = __builtin_amdgcn_mfma_f32_32x32x16_bf16(b1, qr[d0], p1, 0, 0, 0); }
}


typedef __attribute__((address_space(3))) const char* lds_cptr;
typedef short v4i16_t __attribute__((ext_vector_type(4)));
__device__ __forceinline__ s16x4 vtr(lds_cptr p) { return __builtin_bit_cast(s16x4, __builtin_amdgcn_ds_read_tr16_b64_v4i16((__attribute__((address_space(3))) v4i16_t*)p)); }
template <int D0> __device__ __forceinline__ void pv_one2(f32x16& od, lds_cptr vp, bf16x8 pa0, bf16x8 pa1, bf16x8 pa2, bf16x8 pa3) {
  const s16x4 l0 = vtr(vp + v_rd_off(D0, 0, 0)), h0 = vtr(vp + v_rd_off(D0, 0, 1)), l1 = vtr(vp + v_rd_off(D0, 1, 0)), h1 = vtr(vp + v_rd_off(D0, 1, 1));
  const s16x4 l2 = vtr(vp + v_rd_off(D0, 2, 0)), h2 = vtr(vp + v_rd_off(D0, 2, 1)), l3 = vtr(vp + v_rd_off(D0, 3, 0)), h3 = vtr(vp + v_rd_off(D0, 3, 1));
#define PK(L, H) (bf16x8){L[0], L[1], L[2], L[3], H[0], H[1], H[2], H[3]}
  od = __builtin_amdgcn_mfma_f32_32x32x16_bf16(pa0, PK(l0, h0), od, 0, 0, 0);
  od = __builtin_amdgcn_mfma_f32_32x32x16_bf16(pa1, PK(l1, h1), od, 0, 0, 0);
  od = __builtin_amdgcn_mfma_f32_32x32x16_bf16(pa2, PK(l2, h2), od, 0, 0, 0);
  od = __builtin_amdgcn_mfma_f32_32x32x16_bf16(pa3, PK(l3, h3), od, 0, 0, 0);
#undef PK
}
__device__ __forceinline__ void pv_d02(f32x16* o, lds_cptr vp, bf16x8 pa0, bf16x8 pa1, bf16x8 pa2, bf16x8 pa3) {
  pv_one2<0>(o[0], vp, pa0, pa1, pa2, pa3); pv_one2<1>(o[1], vp, pa0, pa1, pa2, pa3); pv_one2<2>(o[2], vp, pa0, pa1, pa2, pa3); pv_one2<3>(o[3], vp, pa0, pa1, pa2, pa3);
}


#define PIN(x) asm volatile("" : "+v"(x))
#define EX1(P, r) P[r] = __builtin_amdgcn_exp2f(P[r])
#define MFMA32(a, b, c) __builtin_amdgcn_mfma_f32_32x32x16_bf16(a, b, c, 0, 0, 0)
#define PERMS(a0, a1, b0, b1, OUT) do { auto r0_ = __builtin_amdgcn_permlane32_swap(a0, b0, false, false); auto r1_ = __builtin_amdgcn_permlane32_swap(a1, b1, false, false); \
    u32x4 w_ = {r0_[0], r1_[0], r0_[1], r1_[1]}; OUT = __builtin_bit_cast(bf16x8, w_); PIN(OUT); } while (0)
#define VFRAG(L, H) (bf16x8){L[0], L[1], L[2], L[3], H[0], H[1], H[2], H[3]}

__device__ __forceinline__ void attn_unit(const unsigned short* __restrict__ Qb, const unsigned short* __restrict__ Kh, const unsigned short* __restrict__ Vh, unsigned short* __restrict__ Ob,
                                          int rowL, int nTL, int rowC, int NT, float lam, const float* __restrict__ subg, float oscale, char* lds,
                                          int pre, const unsigned short* __restrict__ nKh, const unsigned short* __restrict__ nVh, long nrow0) {
  const int tid = threadIdx.x, wid = __builtin_amdgcn_readfirstlane(tid >> 6), lane = tid & 63, r32 = lane & 31, hi = lane >> 5;
  const int mp = wid >> 2, wq = wid & 3;
  constexpr int ABUF = 32768;
  float* ws = (float*)(lds + 3 * ABUF) + wid * 64; float* li_l = ws;
  float l_reg = 0; f32x16 o[4] = {}; bf16x8 qr[4];
  const unsigned short* Qw = Qb + (long)(wq * QBLK + r32) * LDK + mp * 64 + hi * 8;
#pragma unroll
  for (int d0 = 0; d0 < 4; ++d0) qr[d0] = *reinterpret_cast<const bf16x8*>(Qw + d0 * 16);
  const int sr = tid >> 4, sc = (tid & 15) * 8, vst0 = v_st(sr, sc), vst1 = v_st(32 + sr, sc);
  const int kst0 = 16384 + KSWZ(sr, sc * 2), kst1 = 16384 + KSWZ(32 + sr, sc * 2);
  const lds_cptr vp0 = (lds_cptr)lds + v_rd_base(lane);
  const int cbase = mp * 64;
  int voff[2], koff[2];
#pragma unroll
  for (int t = 0; t < 2; ++t) { const int p = wid * 2 + t;
    { const int st = 2 * p + (lane >> 5), b = (16 * lane) & 511, kk = (st >> 2) * 8 + (b >> 6), k = (kk & ~0xC) | ((kk & 4) << 1) | ((kk & 8) >> 1), c = (st & 3) * 32 + ((b & 63) >> 4) * 8; voff[t] = k * LDK + c; }
    { const int row = 4 * p + (lane >> 4), bsw = 16 * (lane & 15), colB = bsw ^ ((row & 7) << 4); koff[t] = row * LDK + (colB >> 1); } }
  const unsigned ldsw = (unsigned)wid * 2048u;
#define TROW(j) ((j) < nTL ? rowL + (j) * KVBLK : rowC + ((j) - nTL) * KVBLK)
#define DMA(j, boff) do { const long k0_ = TROW(j); const unsigned short* vb_ = Vh + k0_ * LDK; const unsigned short* kb_ = Kh + k0_ * LDK; \
    _Pragma("unroll") for (int t_ = 0; t_ < 2; ++t_) { \
      __builtin_amdgcn_global_load_lds((const unsigned*)(vb_ + voff[t_]), (__attribute__((address_space(3))) unsigned*)(lds + (boff) + ldsw + t_ * 1024), 16, 0, 0); \
      __builtin_amdgcn_global_load_lds((const unsigned*)(kb_ + koff[t_]), (__attribute__((address_space(3))) unsigned*)(lds + (boff) + 16384 + ldsw + t_ * 1024), 16, 0, 0); } } while (0)
#define DMAH(j, boff, t_) do { const long k0_ = TROW(j); const unsigned short* vb_ = Vh + k0_ * LDK; const unsigned short* kb_ = Kh + k0_ * LDK; \
      __builtin_amdgcn_global_load_lds((const unsigned*)(vb_ + voff[t_]), (__attribute__((address_space(3))) unsigned*)(lds + (boff) + ldsw + t_ * 1024), 16, 0, 0); \
      __builtin_amdgcn_global_load_lds((const unsigned*)(kb_ + koff[t_]), (__attribute__((address_space(3))) unsigned*)(lds + (boff) + 16384 + ldsw + t_ * 1024), 16, 0, 0); } while (0)
#define DMA_AT(Vp, Kp, row, boff) do { const unsigned short* vb_ = (Vp) + (long)(row) * LDK; const unsigned short* kb_ = (Kp) + (long)(row) * LDK; \
    _Pragma("unroll") for (int t_ = 0; t_ < 2; ++t_) { \
      __builtin_amdgcn_global_load_lds((const unsigned*)(vb_ + voff[t_]), (__attribute__((address_space(3))) unsigned*)(lds + (boff) + ldsw + t_ * 1024), 16, 0, 0); \
      __builtin_amdgcn_global_load_lds((const unsigned*)(kb_ + koff[t_]), (__attribute__((address_space(3))) unsigned*)(lds + (boff) + 16384 + ldsw + t_ * 1024), 16, 0, 0); } } while (0)
#define SWAIT() asm volatile("s_waitcnt vmcnt(0)" ::: "memory")
  f32x16 pA0, pA1, pB0, pB1; bf16x8 pa0, pa1, pa2, pa3;
  int prv = 2 * ABUF, cur = 0, nxt = ABUF;
#define STEP(PN0, PN1, PO0, PO1, j) do { \
    const bool dma_ = (j) + 1 < NT; \
    SBAR(); \
    { const char* Ks_ = lds + cur + 16384; const lds_cptr vp_ = vp0 + prv; \
      const bf16x8 kq0 = *reinterpret_cast<const bf16x8*>(Ks_ + KSWZ(r32, (cbase + 0 * 16 + hi * 8) * 2)); const bf16x8 kq1 = *reinterpret_cast<const bf16x8*>(Ks_ + KSWZ(32 + r32, (cbase + 0 * 16 + hi * 8) * 2)); SBAR(); \
      unsigned a0_, a1_, b0_, b1_; const f32x16 z_ = {}; \
      PN0 = MFMA32(kq0, qr[0], z_); const bf16x8 kq2 = *reinterpret_cast<const bf16x8*>(Ks_ + KSWZ(r32, (cbase + 1 * 16 + hi * 8) * 2)); a0_ = cvtpk(PO0[0], PO0[1]); a1_ = cvtpk(PO0[2], PO0[3]); EX1(PO1, 8); PIN(PO1); SBAR(); \
      PN1 = MFMA32(kq1, qr[0], z_); const bf16x8 kq3 = *reinterpret_cast<const bf16x8*>(Ks_ + KSWZ(32 + r32, (cbase + 1 * 16 + hi * 8) * 2)); if (dma_) { DMAH((j) + 1, nxt, 0); } b0_ = cvtpk(PO0[4], PO0[5]); b1_ = cvtpk(PO0[6], PO0[7]); PERMS(a0_, a1_, b0_, b1_, pa0); EX1(PO1, 9); PIN(PO1); SBAR(); \
      PN0 = MFMA32(kq2, qr[1], PN0); const bf16x8 kq4 = *reinterpret_cast<const bf16x8*>(Ks_ + KSWZ(r32, (cbase + 2 * 16 + hi * 8) * 2)); a0_ = cvtpk(PO0[8], PO0[9]); a1_ = cvtpk(PO0[10], PO0[11]); EX1(PO1, 10); PIN(PO1); SBAR(); \
      PN1 = MFMA32(kq3, qr[1], PN1); const bf16x8 kq5 = *reinterpret_cast<const bf16x8*>(Ks_ + KSWZ(32 + r32, (cbase + 2 * 16 + hi * 8) * 2)); if (dma_) { DMAH((j) + 1, nxt, 1); } b0_ = cvtpk(PO0[12], PO0[13]); b1_ = cvtpk(PO0[14], PO0[15]); PERMS(a0_, a1_, b0_, b1_, pa1); EX1(PO1, 11); PIN(PO1); SBAR(); \
      PN0 = MFMA32(kq4, qr[2], PN0); const bf16x8 kq6 = *reinterpret_cast<const bf16x8*>(Ks_ + KSWZ(r32, (cbase + 3 * 16 + hi * 8) * 2)); a0_ = cvtpk(PO1[0], PO1[1]); a1_ = cvtpk(PO1[2], PO1[3]); EX1(PO1, 12); PIN(PO1); SBAR(); \
      PN1 = MFMA32(kq5, qr[2], PN1); const bf16x8 kq7 = *reinterpret_cast<const bf16x8*>(Ks_ + KSWZ(32 + r32, (cbase + 3 * 16 + hi * 8) * 2)); b0_ = cvtpk(PO1[4], PO1[5]); b1_ = cvtpk(PO1[6], PO1[7]); PERMS(a0_, a1_, b0_, b1_, pa2); EX1(PO1, 13); PIN(PO1); SBAR(); \
      PN0 = MFMA32(kq6, qr[3], PN0); const s16x4 vl0 = vtr(vp_ + v_rd_off(0, 0, 0)), vh0 = vtr(vp_ + v_rd_off(0, 0, 1)); EX1(PO1, 14); EX1(PO1, 15); PIN(PO1); SBAR(); \
      PN1 = MFMA32(kq7, qr[3], PN1); const s16x4 vl1 = vtr(vp_ + v_rd_off(1, 0, 0)), vh1 = vtr(vp_ + v_rd_off(1, 0, 1)); a0_ = cvtpk(PO1[8], PO1[9]); a1_ = cvtpk(PO1[10], PO1[11]); b0_ = cvtpk(PO1[12], PO1[13]); b1_ = cvtpk(PO1[14], PO1[15]); PERMS(a0_, a1_, b0_, b1_, pa3); SBAR(); \
      o[0] = MFMA32(pa0, VFRAG(vl0, vh0), o[0]); const s16x4 vl2 = vtr(vp_ + v_rd_off(2, 0, 0)), vh2 = vtr(vp_ + v_rd_off(2, 0, 1)); EX1(PN0, 0); EX1(PN0, 1); PIN(PN0); l0 += PO0[0]; l1 += PO0[1]; PIN(l0); PIN(l1); SBAR(); \
      o[1] = MFMA32(pa0, VFRAG(vl1, vh1), o[1]); const s16x4 vl3 = vtr(vp_ + v_rd_off(3, 0, 0)), vh3 = vtr(vp_ + v_rd_off(3, 0, 1)); EX1(PN0, 2); EX1(PN0, 3); PIN(PN0); l2 += PO0[2]; l3 += PO0[3]; PIN(l2); PIN(l3); SBAR(); \
      o[2] = MFMA32(pa0, VFRAG(vl2, vh2), o[2]); const s16x4 vl4 = vtr(vp_ + v_rd_off(0, 1, 0)), vh4 = vtr(vp_ + v_rd_off(0, 1, 1)); EX1(PN0, 4); EX1(PN0, 5); PIN(PN0); l0 += PO0[4]; l1 += PO0[5]; PIN(l0); PIN(l1); SBAR(); \
      o[3] = MFMA32(pa0, VFRAG(vl3, vh3), o[3]); const s16x4 vl5 = vtr(vp_ + v_rd_off(1, 1, 0)), vh5 = vtr(vp_ + v_rd_off(1, 1, 1)); EX1(PN0, 6); EX1(PN0, 7); PIN(PN0); l2 += PO0[6]; l3 += PO0[7]; PIN(l2); PIN(l3); SBAR(); \
      o[0] = MFMA32(pa1, VFRAG(vl4, vh4), o[0]); const s16x4 vl6 = vtr(vp_ + v_rd_off(2, 1, 0)), vh6 = vtr(vp_ + v_rd_off(2, 1, 1)); EX1(PN0, 8); EX1(PN0, 9); PIN(PN0); l0 += PO0[8]; l1 += PO0[9]; PIN(l0); PIN(l1); SBAR(); \
      o[1] = MFMA32(pa1, VFRAG(vl5, vh5), o[1]); const s16x4 vl7 = vtr(vp_ + v_rd_off(3, 1, 0)), vh7 = vtr(vp_ + v_rd_off(3, 1, 1)); EX1(PN0, 10); EX1(PN0, 11); PIN(PN0); l2 += PO0[10]; l3 += PO0[11]; PIN(l2); PIN(l3); SBAR(); \
      o[2] = MFMA32(pa1, VFRAG(vl6, vh6), o[2]); const s16x4 vl8 = vtr(vp_ + v_rd_off(0, 2, 0)), vh8 = vtr(vp_ + v_rd_off(0, 2, 1)); EX1(PN0, 12); EX1(PN0, 13); PIN(PN0); l0 += PO0[12]; l1 += PO0[13]; PIN(l0); PIN(l1); SBAR(); \
      o[3] = MFMA32(pa1, VFRAG(vl7, vh7), o[3]); const s16x4 vl9 = vtr(vp_ + v_rd_off(1, 2, 0)), vh9 = vtr(vp_ + v_rd_off(1, 2, 1)); EX1(PN0, 14); EX1(PN0, 15); PIN(PN0); l2 += PO0[14]; l3 += PO0[15]; PIN(l2); PIN(l3); SBAR(); \
      o[0] = MFMA32(pa2, VFRAG(vl8, vh8), o[0]); const s16x4 vl10 = vtr(vp_ + v_rd_off(2, 2, 0)), vh10 = vtr(vp_ + v_rd_off(2, 2, 1)); EX1(PN1, 0); PIN(PN1); l0 += PO1[0]; l1 += PO1[1]; PIN(l0); PIN(l1); SBAR(); \
      o[1] = MFMA32(pa2, VFRAG(vl9, vh9), o[1]); const s16x4 vl11 = vtr(vp_ + v_rd_off(3, 2, 0)), vh11 = vtr(vp_ + v_rd_off(3, 2, 1)); EX1(PN1, 1); PIN(PN1); l2 += PO1[2]; l3 += PO1[3]; PIN(l2); PIN(l3); SBAR(); \
      o[2] = MFMA32(pa2, VFRAG(vl10, vh10), o[2]); const s16x4 vl12 = vtr(vp_ + v_rd_off(0, 3, 0)), vh12 = vtr(vp_ + v_rd_off(0, 3, 1)); EX1(PN1, 2); PIN(PN1); l0 += PO1[4]; l1 += PO1[5]; PIN(l0); PIN(l1); SBAR(); \
      o[3] = MFMA32(pa2, VFRAG(vl11, vh11), o[3]); const s16x4 vl13 = vtr(vp_ + v_rd_off(1, 3, 0)), vh13 = vtr(vp_ + v_rd_off(1, 3, 1)); EX1(PN1, 3); PIN(PN1); l2 += PO1[6]; l3 += PO1[7]; PIN(l2); PIN(l3); SBAR(); \
      o[0] = MFMA32(pa3, VFRAG(vl12, vh12), o[0]); const s16x4 vl14 = vtr(vp_ + v_rd_off(2, 3, 0)), vh14 = vtr(vp_ + v_rd_off(2, 3, 1)); EX1(PN1, 4); PIN(PN1); l0 += PO1[8]; l1 += PO1[9]; PIN(l0); PIN(l1); SBAR(); \
      o[1] = MFMA32(pa3, VFRAG(vl13, vh13), o[1]); const s16x4 vl15 = vtr(vp_ + v_rd_off(3, 3, 0)), vh15 = vtr(vp_ + v_rd_off(3, 3, 1)); EX1(PN1, 5); PIN(PN1); l2 += PO1[10]; l3 += PO1[11]; PIN(l2); PIN(l3); SBAR(); \
      o[2] = MFMA32(pa3, VFRAG(vl14, vh14), o[2]); EX1(PN1, 6); PIN(PN1); l0 += PO1[12]; l1 += PO1[13]; PIN(l0); PIN(l1); SBAR(); \
      o[3] = MFMA32(pa3, VFRAG(vl15, vh15), o[3]); EX1(PN1, 7); PIN(PN1); l2 += PO1[14]; l3 += PO1[15]; PIN(l2); PIN(l3); SBAR(); \
    } \
    SWAIT(); __syncthreads(); \
    { const int t_ = prv; prv = cur; cur = nxt; nxt = t_; } } while (0)

  float l0 = 0.f, l1 = 0.f, l2 = 0.f, l3 = 0.f;
  if (mp == 1) __builtin_amdgcn_s_setprio(1);
  if (!pre) { DMA(0, 0); } SWAIT(); __syncthreads();
  DMA(1, nxt);
  qkt64(pA0, pA1, lds + cur + 16384, qr, r32, hi, cbase);
  for (int r = 0; r < 16; ++r) EX1(pA0, r);
  for (int r = 0; r < 8; ++r) EX1(pA1, r);
  SWAIT(); __syncthreads();
  { const int t_ = prv; prv = cur; cur = nxt; nxt = t_; }
  for (int j = 1; j + 1 < NT; j += 2) { STEP(pB0, pB1, pA0, pA1, j); STEP(pA0, pA1, pB0, pB1, j + 1); }
  STEP(pB0, pB1, pA0, pA1, NT - 1);
  for (int r = 8; r < 16; ++r) EX1(pB1, r);
  { unsigned a0_, a1_, b0_, b1_;
    a0_ = cvtpk(pB0[0], pB0[1]); a1_ = cvtpk(pB0[2], pB0[3]); b0_ = cvtpk(pB0[4], pB0[5]); b1_ = cvtpk(pB0[6], pB0[7]); PERMS(a0_, a1_, b0_, b1_, pa0);
    a0_ = cvtpk(pB0[8], pB0[9]); a1_ = cvtpk(pB0[10], pB0[11]); b0_ = cvtpk(pB0[12], pB0[13]); b1_ = cvtpk(pB0[14], pB0[15]); PERMS(a0_, a1_, b0_, b1_, pa1);
    a0_ = cvtpk(pB1[0], pB1[1]); a1_ = cvtpk(pB1[2], pB1[3]); b0_ = cvtpk(pB1[4], pB1[5]); b1_ = cvtpk(pB1[6], pB1[7]); PERMS(a0_, a1_, b0_, b1_, pa2);
    a0_ = cvtpk(pB1[8], pB1[9]); a1_ = cvtpk(pB1[10], pB1[11]); b0_ = cvtpk(pB1[12], pB1[13]); b1_ = cvtpk(pB1[14], pB1[15]); PERMS(a0_, a1_, b0_, b1_, pa3); }
  for (int r = 0; r < 16; r += 4) { l0 += pB0[r]; l1 += pB0[r + 1]; l2 += pB0[r + 2]; l3 += pB0[r + 3]; }
  for (int r = 0; r < 16; r += 4) { l0 += pB1[r]; l1 += pB1[r + 1]; l2 += pB1[r + 2]; l3 += pB1[r + 3]; }
  SBAR();
  pv_d02(o, vp0 + prv, pa0, pa1, pa2, pa3);
  l_reg = (l0 + l1) + (l2 + l3);
  __builtin_amdgcn_s_setprio(0);
#undef STEP
  { auto rr = __builtin_amdgcn_permlane32_swap(__float_as_uint(l_reg), __float_as_uint(l_reg), false, false); l_reg = __uint_as_float(rr[0]) + __uint_as_float(rr[1]); }
  if (hi == 0) li_l[r32] = l_reg; asm volatile("s_waitcnt lgkmcnt(0)" ::: "memory");
  float rli[16];
#pragma unroll
  for (int r = 0; r < 16; ++r) rli[r] = __builtin_amdgcn_rcpf(li_l[crow(r, hi)]);
  __syncthreads();
  if (nrow0 >= 0) { DMA_AT(nVh, nKh, nrow0, 0); }
  float* xch = (float*)(lds + ABUF) + (size_t)wq * 32 * 128;
  if (mp == 1) {
#pragma unroll
    for (int r = 0; r < 16; ++r) { const float f = rli[r] * lam;
#pragma unroll
      for (int d0 = 0; d0 < 4; ++d0) xch[crow(r, hi) * 128 + d0 * 32 + r32] = o[d0][r] * f; }
  }
  __syncthreads();
  if (mp == 0) {
    float gsub[4];
#pragma unroll
    for (int d0 = 0; d0 < 4; ++d0) gsub[d0] = subg[d0 * 32 + r32] * oscale;
    unsigned short* Ow = Ob + (long)(wq * QBLK) * LDK; const unsigned obase = (unsigned)(hi * 4 * LDK + r32);
#pragma unroll
    for (int r = 0; r < 16; ++r) { const int orow = crow(r, hi); float v[4]; float ss = 0.f;
#pragma unroll
      for (int d0 = 0; d0 < 4; ++d0) { v[d0] = o[d0][r] * rli[r] - xch[orow * 128 + d0 * 32 + r32]; ss += v[d0] * v[d0]; }
      ss += __shfl_xor(ss, 1); ss += __shfl_xor(ss, 2); ss += __shfl_xor(ss, 4); ss += __shfl_xor(ss, 8); ss += __shfl_xor(ss, 16);
      const float rstd = rsqrtf(ss * (1.0f / 128.0f) + 1e-6f);
#pragma unroll
      for (int d0 = 0; d0 < 4; ++d0) { const __hip_bfloat16 hb = __float2bfloat16(v[d0] * rstd * gsub[d0]); Ow[obase + (unsigned)(((r & 3) + 8 * (r >> 2)) * LDK + d0 * 32)] = __builtin_bit_cast(unsigned short, hb); } }
  }
  __syncthreads();
#undef TROW
#undef DMA_AT
#undef SLOAD
#undef SWRITE
#undef SWAIT
#undef RESC
}
#undef KSWZ
#undef SBAR
}

#define LAS __attribute__((address_space(3)))
typedef unsigned short bf16_t;
typedef float f32x4 __attribute__((ext_vector_type(4)));
typedef unsigned u32x4v __attribute__((ext_vector_type(4)));
typedef unsigned u32x2v __attribute__((ext_vector_type(2)));

struct Params { const float* in[23]; float* out; unsigned char* ws; int ph_lo, ph_hi; };
enum { I_X = 0, I_C, I_CTX, I_CCTX, I_WADA, I_BADA, I_N1G, I_N2G, I_WIN, I_QNG, I_KNG, I_LQ1, I_LK1, I_LQ2, I_LK2, I_SUBG, I_CONVW, I_WPA, I_WPC, I_WO, I_WG, I_WU, I_WD };
constexpr int NPH = 21;
#ifndef TEST_SUB
#define TEST_SUB -1
#endif
constexpr int TSUB = TEST_SUB;

__device__ __forceinline__ float wave_sum(float v) {
#pragma unroll
    for (int o = 1; o < 64; o <<= 1) v += __shfl_xor(v, o);
    return v;
}
__device__ __forceinline__ unsigned f2bf(float f) { unsigned u = __builtin_bit_cast(unsigned, f); return (u + 0x7fffu + ((u >> 16) & 1u)) >> 16; }
__device__ __forceinline__ unsigned pk2(float lo, float hi) { return f2bf(lo) | (f2bf(hi) << 16); }
__device__ __forceinline__ float lam_init_of(int li) { return li == 0 ? 0.2f : 0.35550906759097f; }

#define XB_TMO      128
#define XB_XCNT(j)  (256  + 64 * (j))
#define XB_XSUB(j)  (1280 + 64 * (j))
#define XB_XGEN(j)  (2304 + 64 * (j))
#define XB_TOP      3328
#define XB_TOPGEN   3392
#define XCD_BAR_WORDS 3456
#define XB_SPIN_CAP (1u << 18)

__device__ __forceinline__ unsigned xb_ld(unsigned* p)              { return __hip_atomic_load(p, __ATOMIC_RELAXED, __HIP_MEMORY_SCOPE_AGENT); }
__device__ __forceinline__ unsigned xb_add(unsigned* p, unsigned v) { return __hip_atomic_fetch_add(p, v, __ATOMIC_RELAXED, __HIP_MEMORY_SCOPE_AGENT); }
__device__ __forceinline__ unsigned xb_xcc_id() { return (unsigned)__builtin_amdgcn_s_getreg((3 << 11) | 20) & 0xFu; }
#define XB_SPIN(cond, bar) do { unsigned _sp = 0; while (cond) { __builtin_amdgcn_s_sleep(1); \
    if ((++_sp & 255u) == 0u) { if (xb_ld(&(bar)[XB_TMO])) break; if (_sp > XB_SPIN_CAP) { atomicAdd(&(bar)[XB_TMO], 1u); break; } } } } while (0)

struct XcdBarrier {
    unsigned* bar; unsigned x;
    volatile LAS unsigned* st;
};

__device__ __forceinline__ XcdBarrier xcd_barrier_post(unsigned* bar, volatile LAS unsigned* st) {
    XcdBarrier b; b.bar = bar; b.x = xb_xcc_id(); b.st = st;
    if (threadIdx.x == 0) (void)xb_add(&bar[XB_XCNT(b.x)], 1u);
    return b;
}
__device__ __forceinline__ void xcd_barrier_complete(unsigned* bar, unsigned x, unsigned& nloc, unsigned& nx) {
    const unsigned G = gridDim.x * gridDim.y * gridDim.z;
    unsigned sum, cnt, mine, sp = 0u;
    for (;;) {
        sum = 0u; cnt = 0u; mine = 0u;
#pragma unroll
        for (unsigned j = 0; j < 16; ++j) { const unsigned c = xb_ld(&bar[XB_XCNT(j)]); sum += c; cnt += (c > 0u) ? 1u : 0u; mine = (j == x) ? c : mine; }
        if (sum == G) break;
        __builtin_amdgcn_s_sleep(1);
        if ((++sp & 255u) == 0u) { if (xb_ld(&bar[XB_TMO])) break; if (sp > XB_SPIN_CAP) { atomicAdd(&bar[XB_TMO], 1u); break; } }
    }
    nloc = mine > 0u ? mine : 1u; nx = cnt > 0u ? cnt : 1u;
}

__device__ __forceinline__ void xcd_barrier(const XcdBarrier& b) {
    asm volatile("s_waitcnt vmcnt(0)" ::: "memory");
    __syncthreads();
    if (threadIdx.x == 0) {
        unsigned* bar = b.bar;
        __builtin_amdgcn_s_waitcnt(0);
        unsigned nloc = b.st[0], nx = b.st[1];
        if (nloc == 0u) { xcd_barrier_complete(bar, b.x, nloc, nx); b.st[0] = nloc; b.st[1] = nx; }
        const unsigned old = xb_add(&bar[XB_XSUB(b.x)], 1u);
        const unsigned gen = old / nloc;
        if (old + 1u == (gen + 1u) * nloc) {
            __builtin_amdgcn_fence(__ATOMIC_RELEASE, "agent");
            asm volatile("s_waitcnt vmcnt(0)" ::: "memory");
            const unsigned og = xb_add(&bar[XB_TOP], 1u);
            const unsigned tg = og / nx;
            if (og + 1u == (tg + 1u) * nx) xb_add(&bar[XB_TOPGEN], 1u);
            else XB_SPIN(xb_ld(&bar[XB_TOPGEN]) == tg, bar);
            __builtin_amdgcn_fence(__ATOMIC_ACQUIRE, "agent");
            xb_add(&bar[XB_XGEN(b.x)], 1u);
            asm volatile("s_waitcnt vmcnt(0)" ::: "memory");
        } else {
            XB_SPIN(xb_ld(&bar[XB_XGEN(b.x)]) == gen, bar);
            __builtin_amdgcn_fence(__ATOMIC_ACQUIRE, "agent");
            asm volatile("s_waitcnt vmcnt(0)" ::: "memory");
        }
    }
    __syncthreads();
}

constexpr int CW_BAR = 1024;
constexpr int LDS_ST_OFF = 143360;

__device__ __forceinline__ void tr_item(const float* __restrict__ W, int ldw, int k0, int scol0, bf16_t* __restrict__ WT, int K, int drow0, float* scr, int lane) {
#pragma unroll 8
    for (int i = 0; i < 32; ++i) { const int kk = 2 * i + (lane >> 5); scr[kk * 33 + (lane & 31)] = W[(size_t)(k0 + kk) * ldw + scol0 + (lane & 31)]; }
    asm volatile("s_waitcnt lgkmcnt(0)" ::: "memory");
    const int c = lane & 7;
#pragma unroll
    for (int j = 0; j < 4; ++j) { const int n = (lane >> 3) + 8 * j; const float* s = scr + (8 * c) * 33 + n;
        u32x4v o; o.x = pk2(s[0 * 33], s[1 * 33]); o.y = pk2(s[2 * 33], s[3 * 33]); o.z = pk2(s[4 * 33], s[5 * 33]); o.w = pk2(s[6 * 33], s[7 * 33]);
        *(u32x4v*)(WT + (size_t)(drow0 + n) * K + k0 + 8 * c) = o; }
    asm volatile("s_waitcnt lgkmcnt(0)" ::: "memory");
}
__device__ __forceinline__ int map_in(int n0) {
    if (n0 < 2048) { const int pn = n0 >> 8, p = n0 & 255, bj = p >> 7, g = (p & 127) >> 5; return pn * 256 + g * 64 + bj * 32; }
    if (n0 < 3072) return n0;
    const int q = n0 - 3072, t2 = q >> 8, p = q & 255;
    if (t2 < 8) { const int bj = p >> 7, off = p & 127; return (bj ? 5120 : 3072) + t2 * 128 + off; }
    if (t2 < 12) return 4096 + (t2 - 8) * 256 + p;
    if (t2 < 16) return 6144 + (t2 - 12) * 256 + p;
    return 7168 + (t2 - 16) * 256 + p;
}
__device__ __forceinline__ void wconv_phase(const Params& P, int li, unsigned char* lds, int it_lo, int it_hi, int widx, int wcount) {
    const int tid = threadIdx.x, lane = tid & 63, wave = tid >> 6;
    float* scr = (float*)(lds + wave * 16384);
    const int gw = widx * 8 + wave, NGW = wcount * 8;
    bf16_t* Win_t = (bf16_t*)(P.ws + W_IN); bf16_t* Wpa_t = (bf16_t*)(P.ws + W_PA); bf16_t* Wpc_t = (bf16_t*)(P.ws + W_PC); bf16_t* Wo_t = (bf16_t*)(P.ws + W_O);
    bf16_t* Wgu_t = (bf16_t*)(P.ws + W_GU); bf16_t* Wd_t = (bf16_t*)(P.ws + W_D);
    constexpr int I_A = 16 * 256, I_B = 16 * 32, I_C2 = 16 * 176, I_D = 44 * 32, NIT = I_A + 3 * I_B + I_C2 + I_D;
    (void)NIT;
    for (int it = it_lo + gw; it < it_hi; it += NGW) {
        int r = it;
        if (r < I_A) { const int kb = r >> 8, nb = r & 255; tr_item(P.in[I_WIN] + (size_t)li * DM * NIN, NIN, kb * 64, map_in(nb * 32), Win_t, DM, nb * 32, scr, lane); continue; } r -= I_A;
        if (r < I_B) { const int kb = r >> 5, nb = r & 31; tr_item(P.in[I_WPA] + (size_t)li * DM * DM, DM, kb * 64, nb * 32, Wpa_t, DM, nb * 32, scr, lane); continue; } r -= I_B;
        if (r < I_B) { const int kb = r >> 5, nb = r & 31; tr_item(P.in[I_WPC] + (size_t)li * DM * DM, DM, kb * 64, nb * 32, Wpc_t, DM, nb * 32, scr, lane); continue; } r -= I_B;
        if (r < I_B) { const int kb = r >> 5, nb = r & 31; tr_item(P.in[I_WO] + (size_t)li * DM * DM, DM, kb * 64, nb * 32, Wo_t, DM, nb * 32, scr, lane); continue; } r -= I_B;
        if (r < I_C2) { const int kb = r / 176, nb = r % 176, n0 = nb * 32, t = n0 >> 8, p = n0 & 255, bj = p >> 7, off = p & 127;
            tr_item((bj ? P.in[I_WU] : P.in[I_WG]) + (size_t)li * DM * DFF, DFF, kb * 64, t * 128 + off, Wgu_t, DM, n0, scr, lane); continue; } r -= I_C2;
        { const int kb = r >> 5, nb = r & 31; tr_item(P.in[I_WD] + (size_t)li * DFF * DM, DM, kb * 64, nb * 32, Wd_t, DFF, nb * 32, scr, lane); }
    }
}

__device__ __forceinline__ void prologue_phase(const Params& P, unsigned char* lds) {
    const int tid = threadIdx.x, lane = tid & 63, wave = tid >> 6;
    float* modv = (float*)(P.ws + WS_MOD); float* ctlf = (float*)(P.ws + WS_CTL);
    {
        float* sl = (float*)lds; float* red = sl + 3072;
        for (int i = tid; i < 3072; i += 512) { const float v = i < 2048 ? P.in[I_C][i] : P.in[I_CCTX][i - 2048]; sl[i] = v / (1.0f + expf(-v)); }
        __syncthreads();
        for (int chunk = blockIdx.x; chunk < 192; chunk += gridDim.x) {
            const int li = chunk / 96, colbase = (chunk % 96) * 64, kg = tid >> 6, cl = tid & 63;
            const float* w = P.in[I_WADA] + ((size_t)li * DM + kg * 128) * 6144 + colbase + cl;
            float a0 = 0.f, a1 = 0.f, a2 = 0.f;
#pragma unroll 8
            for (int kk = 0; kk < 128; ++kk) { const float wv = w[(size_t)kk * 6144]; const int k = kg * 128 + kk; a0 += sl[k] * wv; a1 += sl[1024 + k] * wv; a2 += sl[2048 + k] * wv; }
            red[(kg * 64 + cl) * 3 + 0] = a0; red[(kg * 64 + cl) * 3 + 1] = a1; red[(kg * 64 + cl) * 3 + 2] = a2;
            __syncthreads();
            if (tid < 192) { const int col = tid & 63, s = tid >> 6; float sum = P.in[I_BADA][li * 6144 + colbase + col];
#pragma unroll
                for (int g = 0; g < 8; ++g) sum += red[(g * 64 + col) * 3 + s];
                modv[(size_t)(li * 3 + s) * 6144 + colbase + col] = sum; }
            __syncthreads();
        }
    }
    {
        float* rope = (float*)(P.ws + WS_ROPE);
        for (int e = blockIdx.x * 512 + tid; e < SEQ * 32; e += gridDim.x * 512) {
            const int pos = e >> 5, i = e & 31, pp = i < 16 ? (pos >> 6) : (pos & 63), f = i & 15;
            const float inv = exp2f(-(float)f * 0.8304820237218406f);
            const float ang = (float)pp * inv;
            const double a = (double)ang, kq = __builtin_rint(a * 0.6366197723675814);
            const double r = __builtin_fma(-kq, 6.123233995736766e-17, __builtin_fma(-kq, 1.5707963267948966, a));
            const int q = (int)kq & 3;
            const double r2 = r * r;
            const double s = r * (1.0 + r2 * (-1.0 / 6 + r2 * (1.0 / 120 + r2 * (-1.0 / 5040 + r2 * (1.0 / 362880 + r2 * (-1.0 / 39916800))))));
            const double c = 1.0 + r2 * (-0.5 + r2 * (1.0 / 24 + r2 * (-1.0 / 720 + r2 * (1.0 / 40320 + r2 * (-1.0 / 3628800 + r2 * (1.0 / 479001600))))));
            double co, si;
            if (q == 0) { co = c; si = s; } else if (q == 1) { co = -s; si = c; } else if (q == 2) { co = -c; si = -s; } else { co = s; si = -c; }
            rope[(size_t)e * 2] = (float)co; rope[(size_t)e * 2 + 1] = (float)si;
        }
    }
    if (blockIdx.x == 0 && wave == 0) {
        for (int li = 0; li < 2; ++li) {
            float a = P.in[I_LQ1][li * 64 + lane] * P.in[I_LK1][li * 64 + lane], b = P.in[I_LQ2][li * 64 + lane] * P.in[I_LK2][li * 64 + lane];
            a = wave_sum(a); b = wave_sum(b);
            if (lane == 0) ctlf[li] = expf(a) - expf(b) + lam_init_of(li);
        }
    }
    __syncthreads();
    wconv_phase(P, 0, lds, 0, 4096, blockIdx.x, gridDim.x);
}

__device__ __forceinline__ void norm_phase(const Params& P, int li, int which, int Mrows, const float* XL, const float* XC, const float* part = nullptr, const float* pgate = nullptr, float* xc_out = nullptr) {
    const int tid = threadIdx.x, lane = tid & 63, wave = tid >> 6;
    const int gw = blockIdx.x * 8 + wave, NGW = gridDim.x * 8;
    const float* g = P.in[which ? I_N2G : I_N1G] + li * DM;
    const float* modv = (const float*)(P.ws + WS_MOD);
    bf16_t* H = (bf16_t*)(P.ws + WS_H);
    for (int row = gw; row < Mrows; row += NGW) {
        const int s = row < SEQ ? 0 : (row < NLAT ? 1 : 2);
        const float* xr = row < NLAT ? XL + (size_t)row * DM : XC + (size_t)(row - NLAT) * DM;
        const float* sh = modv + (size_t)(li * 3 + s) * 6144 + (which ? 3 : 0) * DM; const float* sc = sh + DM;
        const f32x4* x4 = (const f32x4*)xr + lane;
        f32x4 v[4]; float ss = 0.f;
#pragma unroll
        for (int j = 0; j < 4; ++j) v[j] = x4[64 * j];
        if (part && row >= NLAT) {
            const f32x4* p4 = (const f32x4*)(part + (size_t)(row - NLAT) * DM) + lane; f32x4* xo = (f32x4*)(xc_out + (size_t)(row - NLAT) * DM) + lane;
#pragma unroll
            for (int j = 0; j < 4; ++j) { const f32x4 sum = (p4[64 * j] + p4[64 * j + 512 * DM / 4]) + (p4[64 * j + 2 * 512 * DM / 4] + p4[64 * j + 3 * 512 * DM / 4]);
                v[j] = v[j] + ((const f32x4*)pgate)[lane + 64 * j] * sum; xo[64 * j] = v[j]; }
        }
#pragma unroll
        for (int j = 0; j < 4; ++j) ss += (v[j].x * v[j].x + v[j].y * v[j].y) + (v[j].z * v[j].z + v[j].w * v[j].w);
        const float rstd = rsqrtf(wave_sum(ss) * (1.0f / DM) + EPS);
        unsigned long long* o8 = (unsigned long long*)(H + (size_t)row * DM) + lane;
#pragma unroll
        for (int j = 0; j < 4; ++j) { const int c4 = lane + 64 * j; const f32x4 gg = ((const f32x4*)g)[c4], s4 = ((const f32x4*)sc)[c4], h4 = ((const f32x4*)sh)[c4];
            const f32x4 y = v[j] * rstd * gg * (1.0f + s4) + h4;
            o8[64 * j] = (unsigned long long)pk2(y.x, y.y) | ((unsigned long long)pk2(y.z, y.w) << 32); }
    }
}

__device__ __forceinline__ void conv_phase(const Params& P, int li, int Mrows, int widx, int wcount) {
    const bf16_t* U = (const bf16_t*)(P.ws + WS_R); bf16_t* CB = (bf16_t*)(P.ws + WS_R + SEC);
    const float* cw = P.in[I_CONVW] + (size_t)li * 3 * DM;
    const int total = Mrows * 128;
    for (int it = widx * 512 + threadIdx.x; it < total; it += wcount * 512) {
        const int row = it >> 7, c8 = (it & 127) * 8;
        int t, last; if (row < NLAT) { t = row & (SEQ - 1); last = SEQ - 1; } else { t = (row - NLAT) & (NCTX - 1); last = NCTX - 1; }
        const size_t off = (size_t)row * DM + c8;
        const u32x4v zero = {0u, 0u, 0u, 0u};
        const u32x4v u0 = *(const u32x4v*)(U + off), um = t > 0 ? *(const u32x4v*)(U + off - DM) : zero, up = t < last ? *(const u32x4v*)(U + off + DM) : zero, cb = *(const u32x4v*)(CB + off);
        f32x4 a0, a1, m0, m1, p0, p1, b0, b1; pg8::unpack8(u0, a0, a1); pg8::unpack8(um, m0, m1); pg8::unpack8(up, p0, p1); pg8::unpack8(cb, b0, b1);
        const f32x4 w00 = *(const f32x4*)(cw + c8), w01 = *(const f32x4*)(cw + c8 + 4), w10 = *(const f32x4*)(cw + DM + c8), w11 = *(const f32x4*)(cw + DM + c8 + 4), w20 = *(const f32x4*)(cw + 2 * DM + c8), w21 = *(const f32x4*)(cw + 2 * DM + c8 + 4);
        const f32x4 y0 = b0 * (m0 * w00 + a0 * w10 + p0 * w20), y1 = b1 * (m1 * w01 + a1 * w11 + p1 * w21);
        *(u32x4v*)(CB + off) = pg8::pack8(y0, y1);
    }
}

__device__ __forceinline__ void attn_phase(const Params& P, int li, unsigned char* lds) {
    const bf16_t* Q = (const bf16_t*)(P.ws + WS_R); const bf16_t* K = Q + SECE; const bf16_t* V = K + SECE; bf16_t* O = (bf16_t*)(P.ws + WS_ATT);
    const float lam = ((const float*)(P.ws + WS_CTL))[li]; const float oscale = 1.0f - lam_init_of(li); const float* subg = P.in[I_SUBG] + li * 128;
    const int G = gridDim.x, blk = blockIdx.x;
    const int xcd = blk & 7, slot = blk >> 3;
    const int nlat = (G == 256) ? 4 : (blk < 1024 ? (1024 - blk + G - 1) / G : 0);
    const int nctx = (li == 0 && blk < 32) ? (32 - blk + G - 1) / G : 0;
#define UNIT_PARAMS(i_, b_, h_, rowL_, nTL_, NT_, q0_) do { \
        if ((i_) < nlat) { int bh_, qb_; if (G == 256) { bh_ = xcd + 8 * ((i_) >> 1); qb_ = slot + 32 * ((i_) & 1); } else { const int u_ = blk + (i_) * G; bh_ = u_ >> 6; qb_ = u_ & 63; } \
            b_ = bh_ >> 3; h_ = bh_ & 7; q0_ = (size_t)b_ * SEQ + qb_ * 128; rowL_ = b_ * SEQ; nTL_ = 128; NT_ = 132; } \
        else { const int u_ = blk + ((i_) - nlat) * G, bh_ = u_ >> 1, qb_ = u_ & 1; b_ = bh_ >> 3; h_ = bh_ & 7; q0_ = (size_t)NLAT + b_ * NCTX + qb_ * 128; rowL_ = 0; nTL_ = 0; NT_ = 4; } } while (0)
    for (int i = 0; i < nlat + nctx; ++i) {
        int b, h, rowL, nTL, NT; size_t q0;
        UNIT_PARAMS(i, b, h, rowL, nTL, NT, q0);
        long nrow0 = -1; const bf16_t* nK = K; const bf16_t* nV = V;
        if (i + 1 < nlat + nctx) { int b2, h2, rowL2, nTL2, NT2; size_t q02; UNIT_PARAMS(i + 1, b2, h2, rowL2, nTL2, NT2, q02); (void)NT2; (void)q02;
            nK = K + h2 * 128; nV = V + h2 * 128; nrow0 = nTL2 > 0 ? (long)rowL2 : (long)(NLAT + b2 * NCTX); }
        att::attn_unit(Q + q0 * DM + h * 128, K + h * 128, V + h * 128, O + q0 * DM + h * 128, rowL, nTL, NLAT + b * NCTX, NT, lam, subg, oscale, (char*)lds, i > 0, nK, nV, nrow0);
    }
#undef UNIT_PARAMS
}

#define IN(k) (lo <= (k) && (k) < hi)
#ifndef SYNC_REP
#define SYNC_REP 1
#endif
#define SEAM(k) do { if (IN(k) && IN((k) + 1)) { for (int sr_ = 0; sr_ < SYNC_REP; ++sr_) xcd_barrier(bar); } } while (0)
#define TS(k) (TSUB < 0 || TSUB == (k))
#ifndef REP_ATT
#define REP_ATT 1
#endif
#ifndef REP_G
#define REP_G 1
#endif
#if REP_G == 2
#define GDUP(...) __VA_ARGS__ __VA_ARGS__
#else
#define GDUP(...) __VA_ARGS__
#endif
#ifndef REP_EW
#define REP_EW 1
#endif
template <int LI> __device__ __forceinline__ void layer_phases(const Params& P, unsigned char* lds, const int lo, const int hi, const XcdBarrier& bar) {
    constexpr int li = LI, B0 = 1 + 10 * LI;
    constexpr int Mr = (LI == 0) ? MT : NLAT;
    PG8_LAS unsigned char* lds3 = (PG8_LAS unsigned char*)lds;
    const int G = gridDim.x, c = blockIdx.x;
    if (IN(B0 + 0) && TS(0)) { if (LI == 1) { wconv_phase(P, 1, lds, 8448, 9856, blockIdx.x, gridDim.x); } for (int rep = 0; rep < REP_EW; ++rep) norm_phase(P, li, 0, MT, LI == 0 ? P.in[I_X] : P.out, LI == 0 ? P.in[I_CTX] : (const float*)(P.ws + WS_CTXX), LI == 1 ? (const float*)(P.ws + WS_PART) : nullptr, (const float*)(P.ws + WS_MOD) + (size_t)2 * 6144 + 5 * DM, (float*)(P.ws + WS_CTXX)); }
    SEAM(B0 + 0);
    if (IN(B0 + 1) && TS(1)) { GDUP({ pg8::Gemm g{(bf16_t*)(P.ws + WS_H), (bf16_t*)(P.ws + W_IN), MT, 3072, DM}; pg8::StaticOrder S; S.init(MT, 3072, G, c);
        pg8::EpiQKV E{(bf16_t*)(P.ws + WS_R), P.in[I_QNG] + li * 64, P.in[I_KNG] + li * 64, (const float*)(P.ws + WS_ROPE)};
        pg8::gemm_phase<pg8::EpiQKV, pg8::StaticOrder, true, true>(lds3, g, S, E);
        if (LI == 0 && (G <= 24 || c >= 24)) { __syncthreads(); wconv_phase(P, 0, lds, 4096, 9856, G > 24 ? c - 24 : c, G > 24 ? G - 24 : G); } }) }
    SEAM(B0 + 1);
    if (IN(B0 + 2) && TS(2)) { for (int rep = 0; rep < REP_ATT; ++rep) attn_phase(P, li, lds); }
    SEAM(B0 + 2);
    if (IN(B0 + 3) && TS(3)) { GDUP({ pg8::Gemm g{(bf16_t*)(P.ws + WS_H), (bf16_t*)(P.ws + W_IN) + (size_t)3072 * DM, Mr, 5120, DM}; pg8::StaticOrder S; S.init(Mr, 5120, G, c);
        pg8::EpiG2 E{(bf16_t*)(P.ws + WS_R)}; pg8::gemm_phase<pg8::EpiG2, pg8::StaticOrder, true, true>(lds3, g, S, E); }) }
    SEAM(B0 + 3);
    if (IN(B0 + 4) && TS(4)) {
        if (LI == 0 && G > 8) {
            if (c < 8) { bf16_t* R = (bf16_t*)(P.ws + WS_R); pg8::Gemm g{(bf16_t*)(P.ws + WS_ATT), (bf16_t*)(P.ws + W_PA), MT, DM, DM}; pg8::OneUnit S{64 + (c >> 2), c & 3, DM / 64, 1}; pg8::EpiM1 E{R + 2 * SECE};
                pg8::gemm_phase<pg8::EpiM1, pg8::OneUnit, true, true>(lds3, g, S, E); }
            else conv_phase(P, li, Mr, c - 8, G - 8);
        } else conv_phase(P, li, Mr, c, G);
    }
    SEAM(B0 + 4);
    if (IN(B0 + 5) && TS(5)) {
        bf16_t* R = (bf16_t*)(P.ws + WS_R);
        const bool early = (LI == 0 && G > 8);
        { pg8::Gemm g{(bf16_t*)(P.ws + WS_ATT), (bf16_t*)(P.ws + W_PA), Mr, DM, DM}; pg8::StaticOrder S; S.init(early ? NLAT : Mr, DM, G, c); pg8::EpiM1 E{R + 2 * SECE};
          pg8::gemm_phase<pg8::EpiM1, pg8::StaticOrder, true, true>(lds3, g, S, E); }
        { pg8::Gemm g{R + SECE, (bf16_t*)(P.ws + W_PC), Mr, DM, DM}; pg8::EpiM2 E{R + 2 * SECE, R + 3 * SECE};
          if (early) { pg8::SplitOrder S; S.init(NLAT, DM, G, c, DM, 1); pg8::gemm_phase<pg8::EpiM2, pg8::SplitOrder, true, true>(lds3, g, S, E); }
          else { pg8::StaticOrder S; S.init(Mr, DM, G, c); pg8::gemm_phase<pg8::EpiM2, pg8::StaticOrder, true, true>(lds3, g, S, E); } } }
    SEAM(B0 + 5);
    if (IN(B0 + 6) && TS(6)) { bf16_t* R = (bf16_t*)(P.ws + WS_R); float* ctxX = (float*)(P.ws + WS_CTXX);
        pg8::Gemm g{R + 3 * SECE, (bf16_t*)(P.ws + W_O), Mr, DM, DM};
        pg8::EpiRes E{LI == 0 ? P.in[I_X] : P.out, LI == 0 ? P.in[I_CTX] : ctxX, P.out, ctxX, (const float*)(P.ws + WS_MOD) + (size_t)li * 3 * 6144 + 2 * DM, LI == 0 ? (float*)(P.ws + WS_PART) : nullptr};
        if (LI == 0) { pg8::SplitOrder S; S.init(NLAT, DM, G, c, DM); pg8::gemm_phase<pg8::EpiRes, pg8::SplitOrder, true, true>(lds3, g, S, E); }
        else { pg8::StaticOrder S; S.init(Mr, DM, G, c); pg8::gemm_phase<pg8::EpiRes, pg8::StaticOrder, true, true>(lds3, g, S, E); }
        if (LI == 0 && (G <= 32 || c >= 32)) { __syncthreads(); wconv_phase(P, 1, lds, 0, 5120, G > 32 ? c - 32 : c, G > 32 ? G - 32 : G); } }
    SEAM(B0 + 6);
    if (IN(B0 + 7) && TS(7)) for (int rep = 0; rep < REP_EW; ++rep) norm_phase(P, li, 1, Mr, P.out, LI == 0 ? P.in[I_CTX] : (const float*)(P.ws + WS_CTXX), LI == 0 ? (const float*)(P.ws + WS_PART) : nullptr, (const float*)(P.ws + WS_MOD) + (size_t)2 * 6144 + 2 * DM, (float*)(P.ws + WS_CTXX));
    SEAM(B0 + 7);
    if (IN(B0 + 8) && TS(8)) { GDUP({ pg8::Gemm g{(bf16_t*)(P.ws + WS_H), (bf16_t*)(P.ws + W_GU), Mr, 2 * DFF, DM}; pg8::StaticOrder S; S.init(Mr, 2 * DFF, G, c);
        pg8::EpiGU E{(bf16_t*)(P.ws + WS_R)}; pg8::gemm_phase<pg8::EpiGU, pg8::StaticOrder, true, true>(lds3, g, S, E); }) }
    SEAM(B0 + 8);
    if (IN(B0 + 9) && TS(9)) { float* ctxX = (float*)(P.ws + WS_CTXX); pg8::Gemm g{(bf16_t*)(P.ws + WS_R), (bf16_t*)(P.ws + W_D), Mr, DM, DFF};
        pg8::EpiRes E{P.out, ctxX, P.out, ctxX, (const float*)(P.ws + WS_MOD) + (size_t)li * 3 * 6144 + 5 * DM, LI == 0 ? (float*)(P.ws + WS_PART) : nullptr};
        if (LI == 0) { pg8::SplitOrder S; S.init(NLAT, DM, G, c, DFF); pg8::gemm_phase<pg8::EpiRes, pg8::SplitOrder, true, true>(lds3, g, S, E); }
        else { pg8::StaticOrder S; S.init(Mr, DM, G, c, DFF); pg8::gemm_phase<pg8::EpiRes, pg8::StaticOrder, true, true>(lds3, g, S, E); }
        if (LI == 0 && (G <= 32 || c >= 32)) { __syncthreads(); wconv_phase(P, 1, lds, 5120, 8448, G > 32 ? c - 32 : c, G > 32 ? G - 32 : G); } }
    SEAM(B0 + 9);
}
__global__ void __launch_bounds__(512, 2) mk_fwd(Params P) {
    extern __shared__ __attribute__((aligned(16))) unsigned char lds[];
    const int lo = P.ph_lo, hi = P.ph_hi;
    if (lo < 0) cg::this_grid().sync();
    volatile LAS unsigned* st = (volatile LAS unsigned*)((LAS unsigned char*)lds + LDS_ST_OFF);
    if (threadIdx.x < 2) st[threadIdx.x] = 0u;
    __syncthreads();
    XcdBarrier bar = xcd_barrier_post((unsigned*)(P.ws + WS_CTL) + CW_BAR, st);
#ifndef PRO_REP
#define PRO_REP 1
#endif
    if (IN(0) && TS(10)) { for (int rep = 0; rep < PRO_REP; ++rep) { prologue_phase(P, lds); __syncthreads(); } }
    SEAM(0);
    layer_phases<0>(P, lds, lo, hi, bar);
    layer_phases<1>(P, lds, lo, hi, bar);
}
#undef IN
#undef SEAM
#undef TS

extern "C" void kernel_launch(void* const* d_in, const int* in_sizes, int n_in, void* d_out, int out_size, void* d_ws, size_t ws_size, hipStream_t stream) {
    static int grid = 0;
    if (grid == 0) {
        if (n_in != 23 || in_sizes[0] != NLAT * DM || out_size != NLAT * DM || ws_size < WS_END2) {
            fprintf(stderr, "kernel_launch: shape mismatch (n_in %d, in0 %d, out %d, ws %zu, need ws >= %zu)\n", n_in, n_in > 0 ? in_sizes[0] : -1, out_size, ws_size, (size_t)WS_END2); grid = -1; return; }
        int dev = 0, cus = 0, per_cu = 0;
        if (hipGetDevice(&dev) != hipSuccess || hipDeviceGetAttribute(&cus, hipDeviceAttributeMultiprocessorCount, dev) != hipSuccess) { fprintf(stderr, "kernel_launch: device query failed\n"); grid = -1; return; }
        if (hipFuncSetAttribute((const void*)mk_fwd, hipFuncAttributeMaxDynamicSharedMemorySize, LDS_BYTES) != hipSuccess) { fprintf(stderr, "kernel_launch: hipFuncSetAttribute failed\n"); grid = -1; return; }
        if (hipOccupancyMaxActiveBlocksPerMultiprocessor(&per_cu, (const void*)mk_fwd, 512, LDS_BYTES) != hipSuccess || per_cu < 1) { fprintf(stderr, "kernel_launch: occupancy query gave %d\n", per_cu); per_cu = 1; }
        (void)hipGetLastError();
        grid = cus * per_cu;
    }
    if (grid < 0) return;
    if (hipMemsetAsync((char*)d_ws + WS_CTL + CW_BAR * 4, 0, 16384, stream) != hipSuccess) { fprintf(stderr, "kernel_launch: memset failed\n"); return; }
    Params p{};
    for (int i = 0; i < 23; ++i) p.in[i] = (const float*)d_in[i];
    p.out = (float*)d_out; p.ws = (unsigned char*)d_ws;
#if MK_MULTI
    for (int ph = 0; ph < NPH; ++ph) { p.ph_lo = ph; p.ph_hi = ph + 1; hipLaunchKernelGGL(mk_fwd, dim3(grid), dim3(512), LDS_BYTES, stream, p); }
#else
    p.ph_lo = 0; p.ph_hi = NPH;
    void* args[] = {&p};
    hipError_t e = hipLaunchCooperativeKernel((const void*)mk_fwd, dim3(grid), dim3(512), args, LDS_BYTES, stream);
    if (e != hipSuccess) fprintf(stderr, "kernel_launch: cooperative launch failed: %s (grid %d)\n", hipGetErrorString(e), grid);
#endif
}
```

```cpp
#include <hip/hip_runtime.h>
#include <hip/hip_bf16.h>
#include <hip/hip_cooperative_groups.h>
#include <cstdio>
#include <cstdint>
namespace cg = cooperative_groups;


#ifndef MK_MULTI
#define MK_MULTI 0
#endif

constexpr int DM = 1024, NBATCH = 2, SEQ = 8192, NCTX = 256, NLAT = NBATCH * SEQ, MT = NLAT + NBATCH * NCTX;
constexpr int DFF = 2816, NIN = 8192;
constexpr float EPS = 1e-6f;
constexpr size_t MiB = 1u << 20;
constexpr size_t SEC = (size_t)MT * DM * 2;
constexpr size_t SECE = (size_t)MT * DM;
constexpr size_t WS_CTL = 0, WS_MOD = 65536, WS_ROPE = 1 * MiB, WS_CTXX = 3 * MiB, WS_W = 5 * MiB;
constexpr size_t W_IN = WS_W, W_PA = W_IN + 16 * MiB, W_PC = W_PA + 2 * MiB, W_O = W_PC + 2 * MiB, W_GU = W_O + 2 * MiB, W_D = W_GU + 11 * MiB;
constexpr size_t WS_H = 44 * MiB, WS_ATT = WS_H + SEC, WS_R = WS_ATT + SEC, WS_END = WS_R + 4 * SEC;
constexpr size_t WS_PART = WS_END, WS_END2 = WS_PART + (size_t)4 * 512 * DM * 4;
static_assert((size_t)MT * DFF * 2 <= 4 * SEC, "FFN hidden fits the mixer region");
constexpr int LDS_BYTES = 147456;
namespace pg8 {
#define PG8_LAS __attribute__((address_space(3)))
typedef unsigned short bf16_t;
typedef short bf16x8 __attribute__((ext_vector_type(8)));
typedef float f32x4 __attribute__((ext_vector_type(4)));
typedef unsigned u32x4 __attribute__((ext_vector_type(4)));
constexpr int BM = 256, BK = 64, HALF = 128, HTB = HALF * BK * 2  , STAGE_BYTES = 8 * HTB, NXCD = 8, WGM = 8;

__host__ __device__ __forceinline__ int lds_byte(int r, int c) { const int st = (r >> 4) * 2 + (c >> 5), rr = r & 15, cc = c & 31, ob = rr * 64 + cc * 2; return st * 1024 + (ob ^ (((ob >> 9) & 1) << 5)); }
__host__ __device__ __forceinline__ void stage_rc(int b, int& R, int& C) { const int st = b / 1024, sb = b % 1024, swz = sb ^ (((sb >> 9) & 1) << 5); R = (st >> 1) * 16 + swz / 64; C = (st & 1) * 32 + (swz % 64) / 2; }
__host__ __device__ __forceinline__ int perm32(int rho) { const int n = rho >> 4, i = rho & 15; return 8 * (i >> 2) + 4 * n + (i & 3); }

struct Unit { int pm, pn, kb, nkt, kc; };
struct Gemm { const bf16_t* A; const bf16_t* Bt; int M, N, K; };

struct StaticOrder {
    int nM, nN, nwg, G, c, nkt0;
    __host__ __device__ void init(int M, int N, int G_, int c_, int K_ = 1024) { nM = M / BM; nN = N / BM; nwg = nM * nN; G = G_; c = c_; nkt0 = K_ / BK; }
    __host__ __device__ bool next(int i, Unit& u) const {
        const long L = (long)i * G + c; if (L >= nwg) return false;
        int wgid = (int)L; { const int q = nwg / NXCD, r = nwg % NXCD, xcd = wgid % NXCD, off = wgid / NXCD; wgid = (xcd < r ? xcd * (q + 1) : r * (q + 1) + (xcd - r) * q) + off; }
        const int nig = WGM * nN, gid = wgid / nig, fm = gid * WGM, gsz = (nM - fm) < WGM ? (nM - fm) : WGM;
        u.pm = fm + ((wgid % nig) % gsz); u.pn = (wgid % nig) / gsz; u.kb = 0; u.nkt = nkt0; u.kc = 0; return true;
    }
    __device__ __forceinline__ void a_ready(const Unit&) const {}
    __device__ __forceinline__ void done(const Unit&) const {}
};
struct SplitOrder {
    StaticOrder base; int nl, G, c, q, r, ns, nt;
    __device__ void init(int Mlat, int N, int G_, int c_, int K_, int ns_ = 4) { base.init(Mlat, N, G_, c_, K_); G = G_; c = c_; ns = ns_; nl = c_ < base.nwg ? (base.nwg - c_ + G_ - 1) / G_ : 0;
        nt = K_ / BK; q = (nt / 4) & ~1; r = (nt - 4 * q) / 2; }
    __device__ bool next(int i, Unit& u) const {
        if (i < nl) return base.next(i, u);
        const int e = (i - nl) * G + c; if (e >= 8 * ns) return false;
        if (ns == 1) { u.pm = 64 + (e >> 2); u.pn = e & 3; u.kb = 0; u.nkt = nt; u.kc = 0; return true; }
        const int t = e >> 2, ch = e & 3; u.pm = 64 + (t >> 2); u.pn = t & 3; u.kb = ch * q + 2 * (ch < r ? ch : r); u.nkt = q + (ch < r ? 2 : 0); u.kc = ch; return true; }
    __device__ __forceinline__ void a_ready(const Unit&) const {}
    __device__ __forceinline__ void done(const Unit&) const {}
};
struct OneUnit {
    int pm, pn, nkt, valid;
    __device__ bool next(int i, Unit& u) const { if (i != 0 || !valid) return false; u.pm = pm; u.pn = pn; u.kb = 0; u.nkt = nkt; u.kc = 0; return true; }
    __device__ __forceinline__ void a_ready(const Unit&) const {}
    __device__ __forceinline__ void done(const Unit&) const {}
};
__device__ __forceinline__ unsigned cvt_pk_bf16(float lo, float hi) { unsigned r; asm volatile("v_cvt_pk_bf16_f32 %0, %1, %2" : "=v"(r) : "v"(lo), "v"(hi)); return r; }
typedef float f32x2 __attribute__((ext_vector_type(2)));

typedef unsigned u32x4 __attribute__((ext_vector_type(4)));
__device__ __forceinline__ u32x4 pack8(const f32x4 a, const f32x4 b) { u32x4 w; w.x = cvt_pk_bf16(a[0], a[1]); w.y = cvt_pk_bf16(a[2], a[3]); w.z = cvt_pk_bf16(b[0], b[1]); w.w = cvt_pk_bf16(b[2], b[3]); return w; }
__device__ __forceinline__ float bf_lo(unsigned w) { return __uint_as_float(w << 16); }
__device__ __forceinline__ float bf_hi(unsigned w) { return __uint_as_float(w & 0xffff0000u); }
__device__ __forceinline__ void unpack8(const u32x4 w, f32x4& a, f32x4& b) { a = (f32x4){bf_lo(w.x), bf_hi(w.x), bf_lo(w.y), bf_hi(w.y)}; b = (f32x4){bf_lo(w.z), bf_hi(w.z), bf_lo(w.w), bf_hi(w.w)}; }
__device__ __forceinline__ float sigm(float x) { return __builtin_amdgcn_rcpf(1.0f + __builtin_amdgcn_exp2f(x * -1.4426950408889634f)); }
__device__ __forceinline__ f32x4 sigm4(const f32x4 x) { return (f32x4){sigm(x[0]), sigm(x[1]), sigm(x[2]), sigm(x[3])}; }

struct EpiQKV {
    static constexpr bool PERM = true, AFTER_DRAIN = false;
    bf16_t* R; const float* qg; const float* kg; const float* rope;
    __device__ __forceinline__ void operator()(const f32x4 (&acc)[2][2][4][2], const Unit& u, int wr, int wc, int fr, int fq) const {
        const int sec = u.pn >> 2, ct = u.pn & 3;
        const int row0 = u.pm * BM + wr * 64 + fr;
        bf16_t* base = R + (size_t)sec * SECE;
        if (sec == 2) {
            const int col0 = ct * 256 + wc * 32 + 8 * fq;
#pragma unroll
            for (int ai = 0; ai < 2; ++ai)
#pragma unroll
                for (int m = 0; m < 4; ++m) { bf16_t* rowp = base + (size_t)(row0 + ai * HALF + m * 16) * DM + col0;
#pragma unroll
                    for (int bj = 0; bj < 2; ++bj) *(u32x4*)(rowp + bj * HALF) = pack8(acc[ai][bj][m][0], acc[ai][bj][m][1]); }
        } else {
            const float* gp = (sec == 0 ? qg : kg) + 8 * fq;
            const float qs = sec == 0 ? 0.18033688011112042f : 1.0f;
            f32x4 g[2][2];
#pragma unroll
            for (int bj = 0; bj < 2; ++bj)
#pragma unroll
                for (int n = 0; n < 2; ++n) g[bj][n] = *(const f32x4*)(gp + bj * 32 + 4 * n);
            const int col0 = ct * 256 + wc * 64 + 8 * fq;
#pragma unroll
            for (int ai = 0; ai < 2; ++ai)
#pragma unroll
                for (int m = 0; m < 4; ++m) {
                    const int row = row0 + ai * HALF + m * 16;
                    float ss = 0.f;
#pragma unroll
                    for (int bj = 0; bj < 2; ++bj)
#pragma unroll
                        for (int n = 0; n < 2; ++n) { const f32x4 x = acc[ai][bj][m][n]; ss += (x[0] * x[0] + x[1] * x[1]) + (x[2] * x[2] + x[3] * x[3]); }
                    ss += __shfl_xor(ss, 16); ss += __shfl_xor(ss, 32);
                    const float rstd = rsqrtf(ss * (1.0f / 64.0f) + EPS);
                    f32x4 y[2][2];
#pragma unroll
                    for (int bj = 0; bj < 2; ++bj)
#pragma unroll
                        for (int n = 0; n < 2; ++n) y[bj][n] = acc[ai][bj][m][n] * (rstd * qs) * g[bj][n];
                    if (row < NLAT) {
                        const f32x4* rp = (const f32x4*)(rope + ((size_t)(row & (SEQ - 1)) * 32 + 8 * fq) * 2);
#pragma unroll
                        for (int n = 0; n < 2; ++n) {
                            const f32x4 a = rp[2 * n], b = rp[2 * n + 1];
                            const f32x4 t1 = y[0][n], t2 = y[1][n];
                            y[0][n] = (f32x4){t1[0] * a[0] - t2[0] * a[1], t1[1] * a[2] - t2[1] * a[3], t1[2] * b[0] - t2[2] * b[1], t1[3] * b[2] - t2[3] * b[3]};
                            y[1][n] = (f32x4){t2[0] * a[0] + t1[0] * a[1], t2[1] * a[2] + t1[1] * a[3], t2[2] * b[0] + t1[2] * b[1], t2[3] * b[2] + t1[3] * b[3]};
                        }
                    }
                    bf16_t* rowp = base + (size_t)row * DM + col0;
#pragma unroll
                    for (int bj = 0; bj < 2; ++bj) *(u32x4*)(rowp + bj * 32) = pack8(y[bj][0], y[bj][1]);
                }
        }
    }
};

struct EpiG2 {
    static constexpr bool PERM = true, AFTER_DRAIN = false;
    bf16_t* R;
    __device__ __forceinline__ void operator()(const f32x4 (&acc)[2][2][4][2], const Unit& u, int wr, int wc, int fr, int fq) const {
        const int row0 = u.pm * BM + wr * 64 + fr;
        if (u.pn < 8) {
            const int col0 = u.pn * 128 + wc * 32 + 8 * fq;
#pragma unroll
            for (int ai = 0; ai < 2; ++ai)
#pragma unroll
                for (int m = 0; m < 4; ++m)
                    *(u32x4*)(R + (size_t)(row0 + ai * HALF + m * 16) * DM + col0) = pack8(acc[ai][0][m][0] * acc[ai][1][m][0], acc[ai][0][m][1] * acc[ai][1][m][1]);
        } else {
            const int sec = (u.pn - 8) >> 2, ct = (u.pn - 8) & 3;
            bf16_t* base = R + (size_t)(sec + 1) * SECE;
            const int col0 = ct * 256 + wc * 32 + 8 * fq;
#pragma unroll
            for (int ai = 0; ai < 2; ++ai)
#pragma unroll
                for (int m = 0; m < 4; ++m) { bf16_t* rowp = base + (size_t)(row0 + ai * HALF + m * 16) * DM + col0;
#pragma unroll
                    for (int bj = 0; bj < 2; ++bj) {
                        f32x4 v0 = acc[ai][bj][m][0], v1 = acc[ai][bj][m][1];
                        if (sec > 0) { v0 = sigm4(v0); v1 = sigm4(v1); }
                        *(u32x4*)(rowp + bj * HALF) = pack8(v0, v1); } }
        }
    }
};

struct EpiM1 {
    static constexpr bool PERM = true, AFTER_DRAIN = false;
    bf16_t* GA;
    __device__ __forceinline__ void operator()(const f32x4 (&acc)[2][2][4][2], const Unit& u, int wr, int wc, int fr, int fq) const {
        const int row0 = u.pm * BM + wr * 64 + fr, col0 = u.pn * 256 + wc * 32 + 8 * fq;
#pragma unroll
        for (int ai = 0; ai < 2; ++ai)
#pragma unroll
            for (int m = 0; m < 4; ++m) { bf16_t* rowp = GA + (size_t)(row0 + ai * HALF + m * 16) * DM + col0;
#pragma unroll
                for (int bj = 0; bj < 2; ++bj) { f32x4 s0, s1; unpack8(*(const u32x4*)(rowp + bj * HALF), s0, s1);
                    *(u32x4*)(rowp + bj * HALF) = pack8(s0 * acc[ai][bj][m][0], s1 * acc[ai][bj][m][1]); } }
    }
};
struct EpiM2 {
    static constexpr bool PERM = true, AFTER_DRAIN = false;
    const bf16_t* T; bf16_t* GC;
    __device__ __forceinline__ void operator()(const f32x4 (&acc)[2][2][4][2], const Unit& u, int wr, int wc, int fr, int fq) const {
        const int row0 = u.pm * BM + wr * 64 + fr, col0 = u.pn * 256 + wc * 32 + 8 * fq;
#pragma unroll
        for (int ai = 0; ai < 2; ++ai)
#pragma unroll
            for (int m = 0; m < 4; ++m) { const size_t off = (size_t)(row0 + ai * HALF + m * 16) * DM + col0;
#pragma unroll
                for (int bj = 0; bj < 2; ++bj) { f32x4 s0, s1, t0, t1; unpack8(*(const u32x4*)(GC + off + bj * HALF), s0, s1); unpack8(*(const u32x4*)(T + off + bj * HALF), t0, t1);
                    *(u32x4*)(GC + off + bj * HALF) = pack8(t0 + s0 * acc[ai][bj][m][0], t1 + s1 * acc[ai][bj][m][1]); } }
    }
};
struct EpiRes {
    static constexpr bool PERM = false, AFTER_DRAIN = false;
    const float* inL; const float* inC; float* outL; float* outC; const float* gate;
    float* part;
    __device__ __forceinline__ void operator()(const f32x4 (&acc)[2][2][4][2], const Unit& u, int wr, int wc, int fr, int fq) const {
        const int s = u.pm < 32 ? 0 : (u.pm < 64 ? 1 : 2);
        const bool isc = u.pm >= 64;
        if (isc && part) {
            float* pb = part + (size_t)u.kc * 512 * DM; const int prow0 = (u.pm - 64) * BM + wr * 64 + fr, pcol0 = u.pn * 256 + wc * 32 + 4 * fq;
#pragma unroll
            for (int ai = 0; ai < 2; ++ai)
#pragma unroll
                for (int m = 0; m < 4; ++m) { const size_t off = (size_t)(prow0 + ai * HALF + m * 16) * DM + pcol0;
#pragma unroll
                    for (int bj = 0; bj < 2; ++bj)
#pragma unroll
                        for (int n = 0; n < 2; ++n) *(f32x4*)(pb + off + bj * HALF + n * 16) = acc[ai][bj][m][n]; }
            return;
        }
        const float* ib = isc ? inC : inL; float* ob = isc ? outC : outL;
        const int row0 = (isc ? (u.pm - 64) : u.pm) * BM + wr * 64 + fr, col0 = u.pn * 256 + wc * 32 + 4 * fq;
        f32x4 gv[2][2];
#pragma unroll
        for (int bj = 0; bj < 2; ++bj)
#pragma unroll
            for (int n = 0; n < 2; ++n) gv[bj][n] = *(const f32x4*)(gate + s * 6144 + col0 + bj * HALF + n * 16);
#pragma unroll
        for (int ai = 0; ai < 2; ++ai)
#pragma unroll
            for (int m = 0; m < 4; ++m) { const size_t off = (size_t)(row0 + ai * HALF + m * 16) * DM + col0;
#pragma unroll
                for (int bj = 0; bj < 2; ++bj)
#pragma unroll
                    for (int n = 0; n < 2; ++n) { const f32x4 bs = *(const f32x4*)(ib + off + bj * HALF + n * 16);
                        *(f32x4*)(ob + off + bj * HALF + n * 16) = bs + gv[bj][n] * acc[ai][bj][m][n]; }
                if (m == 3) asm volatile("" ::: "memory"); }
    }
};
struct EpiGU {
    static constexpr bool PERM = true, AFTER_DRAIN = false;
    bf16_t* F;
    __device__ __forceinline__ void operator()(const f32x4 (&acc)[2][2][4][2], const Unit& u, int wr, int wc, int fr, int fq) const {
        const int row0 = u.pm * BM + wr * 64 + fr, col0 = u.pn * 128 + wc * 32 + 8 * fq;
#pragma unroll
        for (int ai = 0; ai < 2; ++ai)
#pragma unroll
            for (int m = 0; m < 4; ++m) {
                const f32x4 g0 = acc[ai][0][m][0], g1 = acc[ai][0][m][1];
                const f32x4 v0 = g0 * sigm4(g0) * acc[ai][1][m][0], v1 = g1 * sigm4(g1) * acc[ai][1][m][1];
                *(u32x4*)(F + (size_t)(row0 + ai * HALF + m * 16) * DFF + col0) = pack8(v0, v1); }
    }
};
template <class Epi, class Sched, bool ALIGN_EPI = false, bool SP2 = false>
__device__ __forceinline__ void gemm_phase(PG8_LAS unsigned char* lds, const Gemm g, const Sched& S, const Epi& E) {
    const int tid = threadIdx.x, wid = __builtin_amdgcn_readfirstlane(tid >> 6), lane = tid & 63, wr = wid >> 2, wc = wid & 3, fr = lane & 15, fq = lane >> 4;
    const int K = g.K;
    unsigned voffA[2], voffB[2];
#pragma unroll
    for (int i = 0; i < 2; ++i) { int R, C; stage_rc(tid * 16 + i * 8192, R, C); const int Rb = Epi::PERM ? ((R & ~31) + perm32(R & 31)) : R;
        voffA[i] = (unsigned)(R * K + C) * 2u; voffB[i] = (unsigned)(Rb * K + C) * 2u; }
    const size_t kstep = (size_t)(BK * 2);
    const size_t hstep = (size_t)HALF * K * 2;
    const size_t tstep = 2 * hstep;
    const unsigned ldsw = (unsigned)wid * 1024u;
    const int aoff = lds_byte(wr * 64 + fr, fq * 8), boff = lds_byte(wc * 32 + fr, fq * 8);
#define PG8_SA(b, h) (((b) * 2 + (h)) * HTB)
#define PG8_SB(b, h) ((4 + (b) * 2 + (h)) * HTB)
#define PG8_STAGE(bufoff, gbase, voff) do { _Pragma("unroll") for (int _i = 0; _i < 2; ++_i) \
        __builtin_amdgcn_global_load_lds((const unsigned*)((const char*)(gbase) + (voff)[_i]), (PG8_LAS unsigned*)(lds + (bufoff) + ldsw + _i * 8192), 16, 0, 0); } while (0)
#define PG8_LDA(dst, b, h) do { _Pragma("unroll") for (int m = 0; m < 4; ++m) _Pragma("unroll") for (int k = 0; k < 2; ++k) dst[m][k] = *(const PG8_LAS bf16x8*)(lds + PG8_SA(b, h) + aoff + m * 2048 + k * 1024); } while (0)
#define PG8_LDB(dst, b, h) do { _Pragma("unroll") for (int n = 0; n < 2; ++n) _Pragma("unroll") for (int k = 0; k < 2; ++k) dst[n][k] = *(const PG8_LAS bf16x8*)(lds + PG8_SB(b, h) + boff + n * 2048 + k * 1024); } while (0)
#define PG8_MMA(ai, bj, At, Bt) do { __builtin_amdgcn_s_setprio(1); _Pragma("unroll") for (int m = 0; m < 4; ++m) _Pragma("unroll") for (int n = 0; n < 2; ++n) _Pragma("unroll") for (int k = 0; k < 2; ++k) \
        acc[ai][bj][m][n] = __builtin_amdgcn_mfma_f32_16x16x32_bf16(Bt[n][k], At[m][k], acc[ai][bj][m][n], 0, 0, 0); __builtin_amdgcn_s_setprio(0); } while (0)
#define PG8_WAIT_V(n) asm volatile("s_waitcnt vmcnt(" #n ")" ::: "memory")
#define PG8_WAIT_L(n) asm volatile("s_waitcnt lgkmcnt(" #n ")" ::: "memory")
#define PG8_BAR __builtin_amdgcn_s_barrier()
#define PG8_SCHED __builtin_amdgcn_sched_barrier(0)
    Unit cur, nxt; int ui = 0;
    if (!S.next(0, cur)) return;
    f32x4 acc[2][2][4][2];
#pragma unroll
    for (int a = 0; a < 2; ++a)
#pragma unroll
        for (int b = 0; b < 2; ++b)
#pragma unroll
            for (int m = 0; m < 4; ++m)
#pragma unroll
                for (int n = 0; n < 2; ++n) acc[a][b][m][n] = (f32x4){0.f, 0.f, 0.f, 0.f};
    bf16x8 At[4][2], B0[2][2], B1[2][2];
    const char* cA = (const char*)g.A + (size_t)cur.pm * tstep + (size_t)cur.kb * kstep; const char* cB = (const char*)g.Bt + (size_t)cur.pn * tstep + (size_t)cur.kb * kstep;
    S.a_ready(cur);
    if constexpr (SP2) {
        PG8_STAGE(PG8_SB(0, 0), cB, voffB); PG8_STAGE(PG8_SB(0, 1), cB + hstep, voffB); PG8_STAGE(PG8_SA(0, 0), cA, voffA); PG8_STAGE(PG8_SA(0, 1), cA + hstep, voffA);
        if (wr == 1) PG8_BAR;
        PG8_WAIT_V(2); PG8_BAR;
        PG8_STAGE(PG8_SB(1, 0), cB + kstep, voffB); PG8_STAGE(PG8_SA(1, 0), cA + kstep, voffA); PG8_STAGE(PG8_SB(1, 1), cB + hstep + kstep, voffB);
        PG8_WAIT_V(6); PG8_BAR;
    } else {
        PG8_STAGE(PG8_SB(0, 0), cB, voffB); PG8_STAGE(PG8_SA(0, 0), cA, voffA); PG8_STAGE(PG8_SB(0, 1), cB + hstep, voffB); PG8_STAGE(PG8_SA(0, 1), cA + hstep, voffA);
        if (wr == 1) PG8_BAR;
        PG8_WAIT_V(4); PG8_BAR;
        PG8_STAGE(PG8_SB(1, 0), cB + kstep, voffB); PG8_STAGE(PG8_SA(1, 0), cA + kstep, voffA); PG8_STAGE(PG8_SB(1, 1), cB + hstep + kstep, voffB);
        PG8_WAIT_V(6); PG8_BAR;
    }
    for (;;) {
        const bool has_next = S.next(ui + 1, nxt);
        const char* nA = has_next ? (const char*)g.A + (size_t)nxt.pm * tstep + (size_t)nxt.kb * kstep : cA; const char* nB = has_next ? (const char*)g.Bt + (size_t)nxt.pn * tstep + (size_t)nxt.kb * kstep : cB;
        const int nt = cur.nkt;
        for (int t = 0; t < nt; t += 2) {
            const bool last = (t == nt - 2);
            const char* a1 = cA + (size_t)(t + 1) * kstep;
            const char* a2 = last ? nA : cA + (size_t)(t + 2) * kstep; const char* b2 = last ? nB : cB + (size_t)(t + 2) * kstep;
            const char* a3 = a2 + kstep; const char* b3 = b2 + kstep;
            if (last && has_next) S.a_ready(nxt);
            if constexpr (SP2) {
            PG8_LDB(B0, 0, 0); PG8_LDB(B1, 0, 1); PG8_SCHED; PG8_LDA(At, 0, 0); PG8_STAGE(PG8_SA(1, 1), a1 + hstep, voffA);
            PG8_WAIT_V(8); PG8_WAIT_L(0); PG8_BAR; PG8_MMA(0, 0, At, B0); PG8_MMA(0, 1, At, B1); PG8_BAR; PG8_SCHED;
            PG8_LDA(At, 0, 1); PG8_STAGE(PG8_SB(0, 0), b2, voffB); PG8_STAGE(PG8_SB(0, 1), b2 + hstep, voffB); PG8_STAGE(PG8_SA(0, 0), a2, voffA);
            PG8_WAIT_V(8); PG8_WAIT_L(0); PG8_BAR; PG8_MMA(1, 0, At, B0); PG8_MMA(1, 1, At, B1); PG8_BAR; PG8_SCHED;
            PG8_LDB(B0, 1, 0); PG8_LDB(B1, 1, 1); PG8_SCHED; PG8_LDA(At, 1, 0); PG8_STAGE(PG8_SA(0, 1), a2 + hstep, voffA);
            PG8_WAIT_V(8); PG8_WAIT_L(0); PG8_BAR; PG8_MMA(0, 0, At, B0); PG8_MMA(0, 1, At, B1); PG8_BAR; PG8_SCHED;
            PG8_LDA(At, 1, 1); PG8_STAGE(PG8_SB(1, 0), b3, voffB); PG8_STAGE(PG8_SB(1, 1), b3 + hstep, voffB); PG8_STAGE(PG8_SA(1, 0), a3, voffA);
            PG8_WAIT_V(8); PG8_WAIT_L(0); PG8_BAR; PG8_MMA(1, 0, At, B0); PG8_MMA(1, 1, At, B1); PG8_BAR; PG8_SCHED;
            } else {
            PG8_LDB(B0, 0, 0); PG8_SCHED; PG8_LDA(At, 0, 0); PG8_STAGE(PG8_SA(1, 1), a1 + hstep, voffA);
            PG8_WAIT_L(8); PG8_BAR; PG8_WAIT_L(0); PG8_MMA(0, 0, At, B0); PG8_BAR; PG8_SCHED;
            PG8_LDB(B1, 0, 1); PG8_STAGE(PG8_SB(0, 0), b2, voffB);
            PG8_BAR; PG8_WAIT_L(0); PG8_MMA(0, 1, At, B1); PG8_BAR;
            PG8_LDA(At, 0, 1); PG8_STAGE(PG8_SA(0, 0), a2, voffA);
            PG8_BAR; PG8_WAIT_L(0); PG8_MMA(1, 0, At, B0); PG8_BAR; PG8_SCHED;
            PG8_STAGE(PG8_SB(0, 1), b2 + hstep, voffB);
            PG8_WAIT_V(6); PG8_BAR; PG8_MMA(1, 1, At, B1); PG8_BAR;
            PG8_LDB(B0, 1, 0); PG8_SCHED; PG8_LDA(At, 1, 0); PG8_STAGE(PG8_SA(0, 1), a2 + hstep, voffA);
            PG8_WAIT_L(8); PG8_BAR; PG8_WAIT_L(0); PG8_MMA(0, 0, At, B0); PG8_BAR; PG8_SCHED;
            PG8_LDB(B1, 1, 1); PG8_STAGE(PG8_SB(1, 0), b3, voffB);
            PG8_BAR; PG8_WAIT_L(0); PG8_MMA(0, 1, At, B1); PG8_BAR;
            PG8_LDA(At, 1, 1); PG8_STAGE(PG8_SA(1, 0), a3, voffA);
            PG8_BAR; PG8_WAIT_L(0); PG8_MMA(1, 0, At, B0); PG8_BAR; PG8_SCHED;
            PG8_STAGE(PG8_SB(1, 1), b3 + hstep, voffB);
            PG8_WAIT_V(6); PG8_BAR; PG8_MMA(1, 1, At, B1); PG8_BAR;
            }
        }
        if constexpr (ALIGN_EPI) { if (wr == 0) PG8_BAR; }
        if constexpr (!Epi::AFTER_DRAIN) { E(acc, cur, wr, wc, fr, fq); S.done(cur); }
        if (!has_next) break;
#pragma unroll
        for (int a = 0; a < 2; ++a)
#pragma unroll
            for (int b = 0; b < 2; ++b)
#pragma unroll
                for (int m = 0; m < 4; ++m)
#pragma unroll
                    for (int n = 0; n < 2; ++n) acc[a][b][m][n] = (f32x4){0.f, 0.f, 0.f, 0.f};
        cur = nxt; cA = nA; cB = nB; ++ui;
        if constexpr (ALIGN_EPI) { if (wr == 1) PG8_BAR; }
    }
    PG8_WAIT_V(0);
    if constexpr (!ALIGN_EPI) { if (wr == 0) PG8_BAR; }
    PG8_BAR;
    if constexpr (Epi::AFTER_DRAIN) { E.fused(acc, cur, wr, wc, fr, fq, lds, wid, lane); S.done(cur); }
#undef PG8_SA
#undef PG8_SB
#undef PG8_STAGE
#undef PG8_LDA
#undef PG8_LDB
#undef PG8_MMA
#undef PG8_WAIT_V
#undef PG8_WAIT_L
#undef PG8_BAR
#undef PG8_SCHED
}
}

namespace att {
using bf16 = __hip_bfloat16;
constexpr int NW = 8, QBLK = 32, KVBLK = 64, LDK = 1024;
constexpr float SCALE = 0.125f;
constexpr float THR = 8.f;
constexpr size_t SHM_V = KVBLK * 128 * 2, SHM_K = KVBLK * 128 * 2;
using bf16x8 = __attribute__((ext_vector_type(8))) short;
using s16x4  = __attribute__((ext_vector_type(4))) short;
using f32x16 = __attribute__((ext_vector_type(16))) float;
using f32x8  = __attribute__((ext_vector_type(8))) float;
using u32x4  = __attribute__((ext_vector_type(4))) unsigned;
#define KSWZ(row, colB) ((row) * 256 + ((colB) ^ (((row) & 7) << 4)))
#define SBAR() __builtin_amdgcn_sched_barrier(0)
__device__ __forceinline__ int crow(int r, int hi) { return (r & 3) + 8 * (r >> 2) + 4 * hi; }
__device__ __forceinline__ unsigned cvtpk(float lo, float hi) {
  unsigned r; asm volatile("v_cvt_pk_bf16_f32 %0, %1, %2" : "=v"(r) : "v"(lo), "v"(hi)); return r;
}
template <typename TIn> struct Stage;
template <> struct Stage<bf16>  { using T = bf16x8;
  __device__ static __forceinline__ T ld8(const bf16* p) { return *reinterpret_cast<const bf16x8*>(p); }
  __device__ static __forceinline__ bf16x8 tobf(T x) { return x; } };
template <> struct Stage<float> { using T = f32x8;
  __device__ static __forceinline__ T ld8(const float* p) { return *reinterpret_cast<const f32x8*>(p); }
  __device__ static __forceinline__ bf16x8 tobf(T x) {
    u32x4 w = {cvtpk(x[0], x[1]), cvtpk(x[2], x[3]), cvtpk(x[4], x[5]), cvtpk(x[6], x[7])}; return *reinterpret_cast<bf16x8*>(&w); } };

__device__ __forceinline__ void partialSM(f32x16& p0) {
  for (int r = 0; r < 16; ++r) p0[r] = __builtin_amdgcn_exp2f(p0[r]);
}
__device__ __forceinline__ void finishSM(f32x16& p0, f32x16& p1, float& l_reg, bf16x8& pa0, bf16x8& pa1, bf16x8& pa2, bf16x8& pa3) {
  for (int r = 0; r < 16; ++r) p1[r] = __builtin_amdgcn_exp2f(p1[r]);
  float ps = 0; for (int r = 0; r < 16; ++r) ps += p0[r]; for (int r = 0; r < 16; ++r) ps += p1[r];
  l_reg += ps;
#define PK4(P, BASE, OUT) do { unsigned a0 = cvtpk(P[BASE + 0], P[BASE + 1]), a1 = cvtpk(P[BASE + 2], P[BASE + 3]);   \
    unsigned b0 = cvtpk(P[BASE + 4], P[BASE + 5]), b1 = cvtpk(P[BASE + 6], P[BASE + 7]);                              \
    auto r0 = __builtin_amdgcn_permlane32_swap(a0, b0, false, false); auto r1 = __builtin_amdgcn_permlane32_swap(a1, b1, false, false); \
    u32x4 w = {r0[0], r1[0], r0[1], r1[1]}; OUT = *reinterpret_cast<bf16x8*>(&w); } while (0)
  PK4(p0, 0, pa0); PK4(p0, 8, pa1); PK4(p1, 0, pa2); PK4(p1, 8, pa3);
#undef PK4
}
__device__ __forceinline__ void qkt(f32x16& p0, f32x16& p1, const bf16* Ks, const bf16x8* qr, int r32, int hi) {
  p0 = f32x16{}; p1 = f32x16{};
  for (int d0 = 0; d0 < 8; ++d0) { int cb = (d0 * 16 + hi * 8) * 2;
    bf16x8 b0 = *reinterpret_cast<const bf16x8*>((const char*)Ks + KSWZ(r32, cb));
    bf16x8 b1 = *reinterpret_cast<const bf16x8*>((const char*)Ks + KSWZ(32 + r32, cb));
    p0 = __builtin_amdgcn_mfma_f32_32x32x16_bf16(b0, qr[d0], p0, 0, 0, 0);
    p1 = __builtin_amdgcn_mfma_f32_32x32x16_bf16(b1, qr[d0], p1, 0, 0, 0); }
}
__device__ __forceinline__ int v_st(int k, int c) { const int kk = (k & ~0xC) | ((k & 4) << 1) | ((k & 8) >> 1); return ((kk >> 3) * 4 + (c >> 5)) * 512 + ((kk & 7) * 32 + (c & 31)) * 2; }
__device__ __forceinline__ int v_rd_base(int lane) { return ((lane & 3) << 3) | (((lane >> 2) & 3) << 6) | (((lane >> 4) & 1) << 5) | (((lane >> 5) & 1) << 8); }
constexpr int v_rd_off(int d0, int ks, int half) { return d0 * 512 + ks * 4096 + half * 2048; }
template <int OFF> __device__ __forceinline__ s16x4 tr_read(int vb) {
  s16x4 r; asm volatile("ds_read_b64_tr_b16 %0, %1 offset:%2" : "=&v"(r) : "v"(vb), "i"(OFF) : "memory"); return r;
}
template <int D0> __device__ __forceinline__ void pv_one(f32x16& od, int vb, bf16x8 pa0, bf16x8 pa1, bf16x8 pa2, bf16x8 pa3) {
  const s16x4 l0 = tr_read<v_rd_off(D0, 0, 0)>(vb), h0 = tr_read<v_rd_off(D0, 0, 1)>(vb), l1 = tr_read<v_rd_off(D0, 1, 0)>(vb), h1 = tr_read<v_rd_off(D0, 1, 1)>(vb);
  const s16x4 l2 = tr_read<v_rd_off(D0, 2, 0)>(vb), h2 = tr_read<v_rd_off(D0, 2, 1)>(vb), l3 = tr_read<v_rd_off(D0, 3, 0)>(vb), h3 = tr_read<v_rd_off(D0, 3, 1)>(vb);
  asm volatile("s_waitcnt lgkmcnt(0)" ::: "memory"); SBAR();
#define PK(L, H) (bf16x8){L[0], L[1], L[2], L[3], H[0], H[1], H[2], H[3]}
  od = __builtin_amdgcn_mfma_f32_32x32x16_bf16(pa0, PK(l0, h0), od, 0, 0, 0);
  od = __builtin_amdgcn_mfma_f32_32x32x16_bf16(pa1, PK(l1, h1), od, 0, 0, 0);
  od = __builtin_amdgcn_mfma_f32_32x32x16_bf16(pa2, PK(l2, h2), od, 0, 0, 0);
  od = __builtin_amdgcn_mfma_f32_32x32x16_bf16(pa3, PK(l3, h3), od, 0, 0, 0);
#undef PK
}
__device__ __forceinline__ void pv_d0(f32x16* o, int vb, bf16x8 pa0, bf16x8 pa1, bf16x8 pa2, bf16x8 pa3) {
  pv_one<0>(o[0], vb, pa0, pa1, pa2, pa3); pv_one<1>(o[1], vb, pa0, pa1, pa2, pa3); pv_one<2>(o[2], vb, pa0, pa1, pa2, pa3); pv_one<3>(o[3], vb, pa0, pa1, pa2, pa3);
}

__device__ __forceinline__ void qkt64(f32x16& p0, f32x16& p1, const char* Ks, const bf16x8* qr, int r32, int hi, int cbase) {
  p0 = f32x16{}; p1 = f32x16{};
#pragma unroll
  for (int d0 = 0; d0 < 4; ++d0) { int cb = (cbase + d0 * 16 + hi * 8) * 2;
    bf16x8 b0 = *reinterpret_cast<const bf16x8*>(Ks + KSWZ(r32, cb));
    bf16x8 b1 = *reinterpret_cast<const bf16x8*>(Ks + KSWZ(32 + r32, cb));
    p0 = __builtin_amdgcn_mfma_f32_32x32x16_bf16(b0, qr[d0], p0, 0, 0, 0);
    p1 = __builtin_amdgcn_mfma_f32_32x32x16_bf16(b1, qr[d0], p1, 0, 0, 0); }
}


typedef __attribute__((address_space(3))) const char* lds_cptr;
typedef short v4i16_t __attribute__((ext_vector_type(4)));
__device__ __forceinline__ s16x4 vtr(lds_cptr p) { return __builtin_bit_cast(s16x4, __builtin_amdgcn_ds_read_tr16_b64_v4i16((__attribute__((address_space(3))) v4i16_t*)p)); }
template <int D0> __device__ __forceinline__ void pv_one2(f32x16& od, lds_cptr vp, bf16x8 pa0, bf16x8 pa1, bf16x8 pa2, bf16x8 pa3) {
  const s16x4 l0 = vtr(vp + v_rd_off(D0, 0, 0)), h0 = vtr(vp + v_rd_off(D0, 0, 1)), l1 = vtr(vp + v_rd_off(D0, 1, 0)), h1 = vtr(vp + v_rd_off(D0, 1, 1));
  const s16x4 l2 = vtr(vp + v_rd_off(D0, 2, 0)), h2 = vtr(vp + v_rd_off(D0, 2, 1)), l3 = vtr(vp + v_rd_off(D0, 3, 0)), h3 = vtr(vp + v_rd_off(D0, 3, 1));
#define PK(L, H) (bf16x8){L[0], L[1], L[2], L[3], H[0], H[1], H[2], H[3]}
  od = __builtin_amdgcn_mfma_f32_32x32x16_bf16(pa0, PK(l0, h0), od, 0, 0, 0);
  od = __builtin_amdgcn_mfma_f32_32x32x16_bf16(pa1, PK(l1, h1), od, 0, 0, 0);
  od = __builtin_amdgcn_mfma_f32_32x32x16_bf16(pa2, PK(l2, h2), od, 0, 0, 0);
  od = __builtin_amdgcn_mfma_f32_32x32x16_bf16(pa3, PK(l3, h3), od, 0, 0, 0);
#undef PK
}
__device__ __forceinline__ void pv_d02(f32x16* o, lds_cptr vp, bf16x8 pa0, bf16x8 pa1, bf16x8 pa2, bf16x8 pa3) {
  pv_one2<0>(o[0], vp, pa0, pa1, pa2, pa3); pv_one2<1>(o[1], vp, pa0, pa1, pa2, pa3); pv_one2<2>(o[2], vp, pa0, pa1, pa2, pa3); pv_one2<3>(o[3], vp, pa0, pa1, pa2, pa3);
}


#define PIN(x) asm volatile("" : "+v"(x))
#define EX1(P, r) P[r] = __builtin_amdgcn_exp2f(P[r])
#define MFMA32(a, b, c) __builtin_amdgcn_mfma_f32_32x32x16_bf16(a, b, c, 0, 0, 0)
#define PERMS(a0, a1, b0, b1, OUT) do { auto r0_ = __builtin_amdgcn_permlane32_swap(a0, b0, false, false); auto r1_ = __builtin_amdgcn_permlane32_swap(a1, b1, false, false); \
    u32x4 w_ = {r0_[0], r1_[0], r0_[1], r1_[1]}; OUT = __builtin_bit_cast(bf16x8, w_); PIN(OUT); } while (0)
#define VFRAG(L, H) (bf16x8){L[0], L[1], L[2], L[3], H[0], H[1], H[2], H[3]}

__device__ __forceinline__ void attn_unit(const unsigned short* __restrict__ Qb, const unsigned short* __restrict__ Kh, const unsigned short* __restrict__ Vh, unsigned short* __restrict__ Ob,
                                          int rowL, int nTL, int rowC, int NT, float lam, const float* __restrict__ subg, float oscale, char* lds,
                                          int pre, const unsigned short* __restrict__ nKh, const unsigned short* __restrict__ nVh, long nrow0) {
  const int tid = threadIdx.x, wid = __builtin_amdgcn_readfirstlane(tid >> 6), lane = tid & 63, r32 = lane & 31, hi = lane >> 5;
  const int mp = wid >> 2, wq = wid & 3;
  constexpr int ABUF = 32768;
  float* ws = (float*)(lds + 3 * ABUF) + wid * 64; float* li_l = ws;
  float l_reg = 0; f32x16 o[4] = {}; bf16x8 qr[4];
  const unsigned short* Qw = Qb + (long)(wq * QBLK + r32) * LDK + mp * 64 + hi * 8;
#pragma unroll
  for (int d0 = 0; d0 < 4; ++d0) qr[d0] = *reinterpret_cast<const bf16x8*>(Qw + d0 * 16);
  const int sr = tid >> 4, sc = (tid & 15) * 8, vst0 = v_st(sr, sc), vst1 = v_st(32 + sr, sc);
  const int kst0 = 16384 + KSWZ(sr, sc * 2), kst1 = 16384 + KSWZ(32 + sr, sc * 2);
  const lds_cptr vp0 = (lds_cptr)lds + v_rd_base(lane);
  const int cbase = mp * 64;
  int voff[2], koff[2];
#pragma unroll
  for (int t = 0; t < 2; ++t) { const int p = wid * 2 + t;
    { const int st = 2 * p + (lane >> 5), b = (16 * lane) & 511, kk = (st >> 2) * 8 + (b >> 6), k = (kk & ~0xC) | ((kk & 4) << 1) | ((kk & 8) >> 1), c = (st & 3) * 32 + ((b & 63) >> 4) * 8; voff[t] = k * LDK + c; }
    { const int row = 4 * p + (lane >> 4), bsw = 16 * (lane & 15), colB = bsw ^ ((row & 7) << 4); koff[t] = row * LDK + (colB >> 1); } }
  const unsigned ldsw = (unsigned)wid * 2048u;
#define TROW(j) ((j) < nTL ? rowL + (j) * KVBLK : rowC + ((j) - nTL) * KVBLK)
#define DMA(j, boff) do { const long k0_ = TROW(j); const unsigned short* vb_ = Vh + k0_ * LDK; const unsigned short* kb_ = Kh + k0_ * LDK; \
    _Pragma("unroll") for (int t_ = 0; t_ < 2; ++t_) { \
      __builtin_amdgcn_global_load_lds((const unsigned*)(vb_ + voff[t_]), (__attribute__((address_space(3))) unsigned*)(lds + (boff) + ldsw + t_ * 1024), 16, 0, 0); \
      __builtin_amdgcn_global_load_lds((const unsigned*)(kb_ + koff[t_]), (__attribute__((address_space(3))) unsigned*)(lds + (boff) + 16384 + ldsw + t_ * 1024), 16, 0, 0); } } while (0)
#define DMAH(j, boff, t_) do { const long k0_ = TROW(j); const unsigned short* vb_ = Vh + k0_ * LDK; const unsigned short* kb_ = Kh + k0_ * LDK; \
      __builtin_amdgcn_global_load_lds((const unsigned*)(vb_ + voff[t_]), (__attribute__((address_space(3))) unsigned*)(lds + (boff) + ldsw + t_ * 1024), 16, 0, 0); \
      __builtin_amdgcn_global_load_lds((const unsigned*)(kb_ + koff[t_]), (__attribute__((address_space(3))) unsigned*)(lds + (boff) + 16384 + ldsw + t_ * 1024), 16, 0, 0); } while (0)
#define DMA_AT(Vp, Kp, row, boff) do { const unsigned short* vb_ = (Vp) + (long)(row) * LDK; const unsigned short* kb_ = (Kp) + (long)(row) * LDK; \
    _Pragma("unroll") for (int t_ = 0; t_ < 2; ++t_) { \
      __builtin_amdgcn_global_load_lds((const unsigned*)(vb_ + voff[t_]), (__attribute__((address_space(3))) unsigned*)(lds + (boff) + ldsw + t_ * 1024), 16, 0, 0); \
      __builtin_amdgcn_global_load_lds((const unsigned*)(kb_ + koff[t_]), (__attribute__((address_space(3))) unsigned*)(lds + (boff) + 16384 + ldsw + t_ * 1024), 16, 0, 0); } } while (0)
#define SWAIT() asm volatile("s_waitcnt vmcnt(0)" ::: "memory")
  f32x16 pA0, pA1, pB0, pB1; bf16x8 pa0, pa1, pa2, pa3;
  int prv = 2 * ABUF, cur = 0, nxt = ABUF;
#define STEP(PN0, PN1, PO0, PO1, j) do { \
    const bool dma_ = (j) + 1 < NT; \
    SBAR(); \
    { const char* Ks_ = lds + cur + 16384; const lds_cptr vp_ = vp0 + prv; \
      const bf16x8 kq0 = *reinterpret_cast<const bf16x8*>(Ks_ + KSWZ(r32, (cbase + 0 * 16 + hi * 8) * 2)); const bf16x8 kq1 = *reinterpret_cast<const bf16x8*>(Ks_ + KSWZ(32 + r32, (cbase + 0 * 16 + hi * 8) * 2)); SBAR(); \
      unsigned a0_, a1_, b0_, b1_; const f32x16 z_ = {}; \
      PN0 = MFMA32(kq0, qr[0], z_); const bf16x8 kq2 = *reinterpret_cast<const bf16x8*>(Ks_ + KSWZ(r32, (cbase + 1 * 16 + hi * 8) * 2)); a0_ = cvtpk(PO0[0], PO0[1]); a1_ = cvtpk(PO0[2], PO0[3]); EX1(PO1, 8); PIN(PO1); SBAR(); \
      PN1 = MFMA32(kq1, qr[0], z_); const bf16x8 kq3 = *reinterpret_cast<const bf16x8*>(Ks_ + KSWZ(32 + r32, (cbase + 1 * 16 + hi * 8) * 2)); if (dma_) { DMAH((j) + 1, nxt, 0); } b0_ = cvtpk(PO0[4], PO0[5]); b1_ = cvtpk(PO0[6], PO0[7]); PERMS(a0_, a1_, b0_, b1_, pa0); EX1(PO1, 9); PIN(PO1); SBAR(); \
      PN0 = MFMA32(kq2, qr[1], PN0); const bf16x8 kq4 = *reinterpret_cast<const bf16x8*>(Ks_ + KSWZ(r32, (cbase + 2 * 16 + hi * 8) * 2)); a0_ = cvtpk(PO0[8], PO0[9]); a1_ = cvtpk(PO0[10], PO0[11]); EX1(PO1, 10); PIN(PO1); SBAR(); \
      PN1 = MFMA32(kq3, qr[1], PN1); const bf16x8 kq5 = *reinterpret_cast<const bf16x8*>(Ks_ + KSWZ(32 + r32, (cbase + 2 * 16 + hi * 8) * 2)); if (dma_) { DMAH((j) + 1, nxt, 1); } b0_ = cvtpk(PO0[12], PO0[13]); b1_ = cvtpk(PO0[14], PO0[15]); PERMS(a0_, a1_, b0_, b1_, pa1); EX1(PO1, 11); PIN(PO1); SBAR(); \
      PN0 = MFMA32(kq4, qr[2], PN0); const bf16x8 kq6 = *reinterpret_cast<const bf16x8*>(Ks_ + KSWZ(r32, (cbase + 3 * 16 + hi * 8) * 2)); a0_ = cvtpk(PO1[0], PO1[1]); a1_ = cvtpk(PO1[2], PO1[3]); EX1(PO1, 12); PIN(PO1); SBAR(); \
      PN1 = MFMA32(kq5, qr[2], PN1); const bf16x8 kq7 = *reinterpret_cast<const bf16x8*>(Ks_ + KSWZ(32 + r32, (cbase + 3 * 16 + hi * 8) * 2)); const s16x4 vl0 = vtr(vp_ + v_rd_off(0, 0, 0)), vh0 = vtr(vp_ + v_rd_off(0, 0, 1)); b0_ = cvtpk(PO1[4], PO1[5]); b1_ = cvtpk(PO1[6], PO1[7]); PERMS(a0_, a1_, b0_, b1_, pa2); EX1(PO1, 13); PIN(PO1); SBAR(); \
      PN0 = MFMA32(kq6, qr[3], PN0); const s16x4 vl1 = vtr(vp_ + v_rd_off(1, 0, 0)), vh1 = vtr(vp_ + v_rd_off(1, 0, 1)); EX1(PO1, 14); EX1(PO1, 15); PIN(PO1); SBAR(); \
      PN1 = MFMA32(kq7, qr[3], PN1); const s16x4 vl2 = vtr(vp_ + v_rd_off(2, 0, 0)), vh2 = vtr(vp_ + v_rd_off(2, 0, 1)); a0_ = cvtpk(PO1[8], PO1[9]); a1_ = cvtpk(PO1[10], PO1[11]); b0_ = cvtpk(PO1[12], PO1[13]); b1_ = cvtpk(PO1[14], PO1[15]); PERMS(a0_, a1_, b0_, b1_, pa3); SBAR(); \
      o[0] = MFMA32(pa0, VFRAG(vl0, vh0), o[0]); const s16x4 vl3 = vtr(vp_ + v_rd_off(3, 0, 0)), vh3 = vtr(vp_ + v_rd_off(3, 0, 1)); EX1(PN0, 0); EX1(PN0, 1); PIN(PN0); l0 += PO0[0]; l1 += PO0[1]; PIN(l0); PIN(l1); SBAR(); \
      o[1] = MFMA32(pa0, VFRAG(vl1, vh1), o[1]); const s16x4 vl4 = vtr(vp_ + v_rd_off(0, 1, 0)), vh4 = vtr(vp_ + v_rd_off(0, 1, 1)); EX1(PN0, 2); EX1(PN0, 3); PIN(PN0); l2 += PO0[2]; l3 += PO0[3]; PIN(l2); PIN(l3); SBAR(); \
      o[2] = MFMA32(pa0, VFRAG(vl2, vh2), o[2]); const s16x4 vl5 = vtr(vp_ + v_rd_off(1, 1, 0)), vh5 = vtr(vp_ + v_rd_off(1, 1, 1)); EX1(PN0, 4); EX1(PN0, 5); PIN(PN0); l0 += PO0[4]; l1 += PO0[5]; PIN(l0); PIN(l1); SBAR(); \
      o[3] = MFMA32(pa0, VFRAG(vl3, vh3), o[3]); const s16x4 vl6 = vtr(vp_ + v_rd_off(2, 1, 0)), vh6 = vtr(vp_ + v_rd_off(2, 1, 1)); EX1(PN0, 6); EX1(PN0, 7); PIN(PN0); l2 += PO0[6]; l3 += PO0[7]; PIN(l2); PIN(l3); SBAR(); \
      o[0] = MFMA32(pa1, VFRAG(vl4, vh4), o[0]); const s16x4 vl7 = vtr(vp_ + v_rd_off(3, 1, 0)), vh7 = vtr(vp_ + v_rd_off(3, 1, 1)); EX1(PN0, 8); EX1(PN0, 9); PIN(PN0); l0 += PO0[8]; l1 += PO0[9]; PIN(l0); PIN(l1); SBAR(); \
      o[1] = MFMA32(pa1, VFRAG(vl5, vh5), o[1]); const s16x4 vl8 = vtr(vp_ + v_rd_off(0, 2, 0)), vh8 = vtr(vp_ + v_rd_off(0, 2, 1)); EX1(PN0, 10); EX1(PN0, 11); PIN(PN0); l2 += PO0[10]; l3 += PO0[11]; PIN(l2); PIN(l3); SBAR(); \
      o[2] = MFMA32(pa1, VFRAG(vl6, vh6), o[2]); const s16x4 vl9 = vtr(vp_ + v_rd_off(1, 2, 0)), vh9 = vtr(vp_ + v_rd_off(1, 2, 1)); EX1(PN0, 12); EX1(PN0, 13); PIN(PN0); l0 += PO0[12]; l1 += PO0[13]; PIN(l0); PIN(l1); SBAR(); \
      o[3] = MFMA32(pa1, VFRAG(vl7, vh7), o[3]); const s16x4 vl10 = vtr(vp_ + v_rd_off(2, 2, 0)), vh10 = vtr(vp_ + v_rd_off(2, 2, 1)); EX1(PN0, 14); EX1(PN0, 15); PIN(PN0); l2 += PO0[14]; l3 += PO0[15]; PIN(l2); PIN(l3); SBAR(); \
      o[0] = MFMA32(pa2, VFRAG(vl8, vh8), o[0]); const s16x4 vl11 = vtr(vp_ + v_rd_off(3, 2, 0)), vh11 = vtr(vp_ + v_rd_off(3, 2, 1)); EX1(PN1, 0); PIN(PN1); l0 += PO1[0]; l1 += PO1[1]; PIN(l0); PIN(l1); SBAR(); \
      o[1] = MFMA32(pa2, VFRAG(vl9, vh9), o[1]); const s16x4 vl12 = vtr(vp_ + v_rd_off(0, 3, 0)), vh12 = vtr(vp_ + v_rd_off(0, 3, 1)); EX1(PN1, 1); PIN(PN1); l2 += PO1[2]; l3 += PO1[3]; PIN(l2); PIN(l3); SBAR(); \
      o[2] = MFMA32(pa2, VFRAG(vl10, vh10), o[2]); const s16x4 vl13 = vtr(vp_ + v_rd_off(1, 3, 0)), vh13 = vtr(vp_ + v_rd_off(1, 3, 1)); EX1(PN1, 2); PIN(PN1); l0 += PO1[4]; l1 += PO1[5]; PIN(l0); PIN(l1); SBAR(); \
      o[3] = MFMA32(pa2, VFRAG(vl11, vh11), o[3]); const s16x4 vl14 = vtr(vp_ + v_rd_off(2, 3, 0)), vh14 = vtr(vp_ + v_rd_off(2, 3, 1)); EX1(PN1, 3); PIN(PN1); l2 += PO1[6]; l3 += PO1[7]; PIN(l2); PIN(l3); SBAR(); \
      o[0] = MFMA32(pa3, VFRAG(vl12, vh12), o[0]); const s16x4 vl15 = vtr(vp_ + v_rd_off(3, 3, 0)), vh15 = vtr(vp_ + v_rd_off(3, 3, 1)); EX1(PN1, 4); PIN(PN1); l0 += PO1[8]; l1 += PO1[9]; PIN(l0); PIN(l1); SBAR(); \
      o[1] = MFMA32(pa3, VFRAG(vl13, vh13), o[1]); EX1(PN1, 5); PIN(PN1); l2 += PO1[10]; l3 += PO1[11]; PIN(l2); PIN(l3); SBAR(); \
      o[2] = MFMA32(pa3, VFRAG(vl14, vh14), o[2]); EX1(PN1, 6); PIN(PN1); l0 += PO1[12]; l1 += PO1[13]; PIN(l0); PIN(l1); SBAR(); \
      o[3] = MFMA32(pa3, VFRAG(vl15, vh15), o[3]); EX1(PN1, 7); PIN(PN1); l2 += PO1[14]; l3 += PO1[15]; PIN(l2); PIN(l3); SBAR(); \
    } \
    SWAIT(); __syncthreads(); \
    { const int t_ = prv; prv = cur; cur = nxt; nxt = t_; } } while (0)

  float l0 = 0.f, l1 = 0.f, l2 = 0.f, l3 = 0.f;
  if (mp == 1) __builtin_amdgcn_s_setprio(1);
  if (!pre) { DMA(0, 0); } SWAIT(); __syncthreads();
  DMA(1, nxt);
  qkt64(pA0, pA1, lds + cur + 16384, qr, r32, hi, cbase);
  for (int r = 0; r < 16; ++r) EX1(pA0, r);
  for (int r = 0; r < 8; ++r) EX1(pA1, r);
  SWAIT(); __syncthreads();
  { const int t_ = prv; prv = cur; cur = nxt; nxt = t_; }
  for (int j = 1; j + 1 < NT; j += 2) { STEP(pB0, pB1, pA0, pA1, j); STEP(pA0, pA1, pB0, pB1, j + 1); }
  STEP(pB0, pB1, pA0, pA1, NT - 1);
  for (int r = 8; r < 16; ++r) EX1(pB1, r);
  { unsigned a0_, a1_, b0_, b1_;
    a0_ = cvtpk(pB0[0], pB0[1]); a1_ = cvtpk(pB0[2], pB0[3]); b0_ = cvtpk(pB0[4], pB0[5]); b1_ = cvtpk(pB0[6], pB0[7]); PERMS(a0_, a1_, b0_, b1_, pa0);
    a0_ = cvtpk(pB0[8], pB0[9]); a1_ = cvtpk(pB0[10], pB0[11]); b0_ = cvtpk(pB0[12], pB0[13]); b1_ = cvtpk(pB0[14], pB0[15]); PERMS(a0_, a1_, b0_, b1_, pa1);
    a0_ = cvtpk(pB1[0], pB1[1]); a1_ = cvtpk(pB1[2], pB1[3]); b0_ = cvtpk(pB1[4], pB1[5]); b1_ = cvtpk(pB1[6], pB1[7]); PERMS(a0_, a1_, b0_, b1_, pa2);
    a0_ = cvtpk(pB1[8], pB1[9]); a1_ = cvtpk(pB1[10], pB1[11]); b0_ = cvtpk(pB1[12], pB1[13]); b1_ = cvtpk(pB1[14], pB1[15]); PERMS(a0_, a1_, b0_, b1_, pa3); }
  for (int r = 0; r < 16; r += 4) { l0 += pB0[r]; l1 += pB0[r + 1]; l2 += pB0[r + 2]; l3 += pB0[r + 3]; }
  for (int r = 0; r < 16; r += 4) { l0 += pB1[r]; l1 += pB1[r + 1]; l2 += pB1[r + 2]; l3 += pB1[r + 3]; }
  SBAR();
  pv_d02(o, vp0 + prv, pa0, pa1, pa2, pa3);
  l_reg = (l0 + l1) + (l2 + l3);
  __builtin_amdgcn_s_setprio(0);
#undef STEP
  { auto rr = __builtin_amdgcn_permlane32_swap(__float_as_uint(l_reg), __float_as_uint(l_reg), false, false); l_reg = __uint_as_float(rr[0]) + __uint_as_float(rr[1]); }
  if (hi == 0) li_l[r32] = l_reg; asm volatile("s_waitcnt lgkmcnt(0)" ::: "memory");
  float rli[16];
#pragma unroll
  for (int r = 0; r < 16; ++r) rli[r] = __builtin_amdgcn_rcpf(li_l[crow(r, hi)]);
  __syncthreads();
  if (nrow0 >= 0) { DMA_AT(nVh, nKh, nrow0, 0); }
  float* xch = (float*)(lds + ABUF) + (size_t)wq * 32 * 128;
  if (mp == 1) {
#pragma unroll
    for (int r = 0; r < 16; ++r) { const float f = rli[r] * lam;
#pragma unroll
      for (int d0 = 0; d0 < 4; ++d0) xch[crow(r, hi) * 128 + d0 * 32 + r32] = o[d0][r] * f; }
  }
  __syncthreads();
  if (mp == 0) {
    float gsub[4];
#pragma unroll
    for (int d0 = 0; d0 < 4; ++d0) gsub[d0] = subg[d0 * 32 + r32] * oscale;
    unsigned short* Ow = Ob + (long)(wq * QBLK) * LDK; const unsigned obase = (unsigned)(hi * 4 * LDK + r32);
#pragma unroll
    for (int r = 0; r < 16; ++r) { const int orow = crow(r, hi); float v[4]; float ss = 0.f;
#pragma unroll
      for (int d0 = 0; d0 < 4; ++d0) { v[d0] = o[d0][r] * rli[r] - xch[orow * 128 + d0 * 32 + r32]; ss += v[d0] * v[d0]; }
      ss += __shfl_xor(ss, 1); ss += __shfl_xor(ss, 2); ss += __shfl_xor(ss, 4); ss += __shfl_xor(ss, 8); ss += __shfl_xor(ss, 16);
      const float rstd = rsqrtf(ss * (1.0f / 128.0f) + 1e-6f);
#pragma unroll
      for (int d0 = 0; d0 < 4; ++d0) { const __hip_bfloat16 hb = __float2bfloat16(v[d0] * rstd * gsub[d0]); Ow[obase + (unsigned)(((r & 3) + 8 * (r >> 2)) * LDK + d0 * 32)] = __builtin_bit_cast(unsigned short, hb); } }
  }
  __syncthreads();
#undef TROW
#undef DMA_AT
#undef SLOAD
#undef SWRITE
#undef SWAIT
#undef RESC
}
#undef KSWZ
#undef SBAR
}

#define LAS __attribute__((address_space(3)))
typedef unsigned short bf16_t;
typedef float f32x4 __attribute__((ext_vector_type(4)));
typedef unsigned u32x4v __attribute__((ext_vector_type(4)));
typedef unsigned u32x2v __attribute__((ext_vector_type(2)));

struct Params { const float* in[23]; float* out; unsigned char* ws; int ph_lo, ph_hi; };
enum { I_X = 0, I_C, I_CTX, I_CCTX, I_WADA, I_BADA, I_N1G, I_N2G, I_WIN, I_QNG, I_KNG, I_LQ1, I_LK1, I_LQ2, I_LK2, I_SUBG, I_CONVW, I_WPA, I_WPC, I_WO, I_WG, I_WU, I_WD };
constexpr int NPH = 21;
#ifndef TEST_SUB
#define TEST_SUB -1
#endif
constexpr int TSUB = TEST_SUB;

__device__ __forceinline__ float wave_sum(float v) {
#pragma unroll
    for (int o = 1; o < 64; o <<= 1) v += __shfl_xor(v, o);
    return v;
}
__device__ __forceinline__ unsigned f2bf(float f) { unsigned u = __builtin_bit_cast(unsigned, f); return (u + 0x7fffu + ((u >> 16) & 1u)) >> 16; }
__device__ __forceinline__ unsigned pk2(float lo, float hi) { return f2bf(lo) | (f2bf(hi) << 16); }
__device__ __forceinline__ float lam_init_of(int li) { return li == 0 ? 0.2f : 0.35550906759097f; }

#define XB_TMO      128
#define XB_XCNT(j)  (256  + 64 * (j))
#define XB_XSUB(j)  (1280 + 64 * (j))
#define XB_XGEN(j)  (2304 + 64 * (j))
#define XB_TOP      3328
#define XB_TOPGEN   3392
#define XCD_BAR_WORDS 3456
#define XB_SPIN_CAP (1u << 18)

__device__ __forceinline__ unsigned xb_ld(unsigned* p)              { return __hip_atomic_load(p, __ATOMIC_RELAXED, __HIP_MEMORY_SCOPE_AGENT); }
__device__ __forceinline__ unsigned xb_add(unsigned* p, unsigned v) { return __hip_atomic_fetch_add(p, v, __ATOMIC_RELAXED, __HIP_MEMORY_SCOPE_AGENT); }
__device__ __forceinline__ unsigned xb_xcc_id() { return (unsigned)__builtin_amdgcn_s_getreg((3 << 11) | 20) & 0xFu; }
#define XB_SPIN(cond, bar) do { unsigned _sp = 0; while (cond) { __builtin_amdgcn_s_sleep(1); \
    if ((++_sp & 255u) == 0u) { if (xb_ld(&(bar)[XB_TMO])) break; if (_sp > XB_SPIN_CAP) { atomicAdd(&(bar)[XB_TMO], 1u); break; } } } } while (0)

struct XcdBarrier {
    unsigned* bar; unsigned x;
    volatile LAS unsigned* st;
};

__device__ __forceinline__ XcdBarrier xcd_barrier_post(unsigned* bar, volatile LAS unsigned* st) {
    XcdBarrier b; b.bar = bar; b.x = xb_xcc_id(); b.st = st;
    if (threadIdx.x == 0) (void)xb_add(&bar[XB_XCNT(b.x)], 1u);
    return b;
}
__device__ __forceinline__ void xcd_barrier_complete(unsigned* bar, unsigned x, unsigned& nloc, unsigned& nx) {
    const unsigned G = gridDim.x * gridDim.y * gridDim.z;
    unsigned sum, cnt, mine, sp = 0u;
    for (;;) {
        sum = 0u; cnt = 0u; mine = 0u;
#pragma unroll
        for (unsigned j = 0; j < 16; ++j) { const unsigned c = xb_ld(&bar[XB_XCNT(j)]); sum += c; cnt += (c > 0u) ? 1u : 0u; mine = (j == x) ? c : mine; }
        if (sum == G) break;
        __builtin_amdgcn_s_sleep(1);
        if ((++sp & 255u) == 0u) { if (xb_ld(&bar[XB_TMO])) break; if (sp > XB_SPIN_CAP) { atomicAdd(&bar[XB_TMO], 1u); break; } }
    }
    nloc = mine > 0u ? mine : 1u; nx = cnt > 0u ? cnt : 1u;
}

__device__ __forceinline__ void xcd_barrier(const XcdBarrier& b) {
    asm volatile("s_waitcnt vmcnt(0)" ::: "memory");
    __syncthreads();
    if (threadIdx.x == 0) {
        unsigned* bar = b.bar;
        __builtin_amdgcn_s_waitcnt(0);
        unsigned nloc = b.st[0], nx = b.st[1];
        if (nloc == 0u) { xcd_barrier_complete(bar, b.x, nloc, nx); b.st[0] = nloc; b.st[1] = nx; }
        const unsigned old = xb_add(&bar[XB_XSUB(b.x)], 1u);
        const unsigned gen = old / nloc;
        if (old + 1u == (gen + 1u) * nloc) {
            __builtin_amdgcn_fence(__ATOMIC_RELEASE, "agent");
            asm volatile("s_waitcnt vmcnt(0)" ::: "memory");
            const unsigned og = xb_add(&bar[XB_TOP], 1u);
            const unsigned tg = og / nx;
            if (og + 1u == (tg + 1u) * nx) xb_add(&bar[XB_TOPGEN], 1u);
            else XB_SPIN(xb_ld(&bar[XB_TOPGEN]) == tg, bar);
            __builtin_amdgcn_fence(__ATOMIC_ACQUIRE, "agent");
            xb_add(&bar[XB_XGEN(b.x)], 1u);
            asm volatile("s_waitcnt vmcnt(0)" ::: "memory");
        } else {
            XB_SPIN(xb_ld(&bar[XB_XGEN(b.x)]) == gen, bar);
            __builtin_amdgcn_fence(__ATOMIC_ACQUIRE, "agent");
            asm volatile("s_waitcnt vmcnt(0)" ::: "memory");
        }
    }
    __syncthreads();
}

constexpr int CW_BAR = 1024;
constexpr int LDS_ST_OFF = 143360;

__device__ __forceinline__ void tr_item(const float* __restrict__ W, int ldw, int k0, int scol0, bf16_t* __restrict__ WT, int K, int drow0, float* scr, int lane) {
#pragma unroll 8
    for (int i = 0; i < 32; ++i) { const int kk = 2 * i + (lane >> 5); scr[kk * 33 + (lane & 31)] = W[(size_t)(k0 + kk) * ldw + scol0 + (lane & 31)]; }
    asm volatile("s_waitcnt lgkmcnt(0)" ::: "memory");
    const int c = lane & 7;
#pragma unroll
    for (int j = 0; j < 4; ++j) { const int n = (lane >> 3) + 8 * j; const float* s = scr + (8 * c) * 33 + n;
        u32x4v o; o.x = pk2(s[0 * 33], s[1 * 33]); o.y = pk2(s[2 * 33], s[3 * 33]); o.z = pk2(s[4 * 33], s[5 * 33]); o.w = pk2(s[6 * 33], s[7 * 33]);
        *(u32x4v*)(WT + (size_t)(drow0 + n) * K + k0 + 8 * c) = o; }
    asm volatile("s_waitcnt lgkmcnt(0)" ::: "memory");
}
__device__ __forceinline__ int map_in(int n0) {
    if (n0 < 2048) { const int pn = n0 >> 8, p = n0 & 255, bj = p >> 7, g = (p & 127) >> 5; return pn * 256 + g * 64 + bj * 32; }
    if (n0 < 3072) return n0;
    const int q = n0 - 3072, t2 = q >> 8, p = q & 255;
    if (t2 < 8) { const int bj = p >> 7, off = p & 127; return (bj ? 5120 : 3072) + t2 * 128 + off; }
    if (t2 < 12) return 4096 + (t2 - 8) * 256 + p;
    if (t2 < 16) return 6144 + (t2 - 12) * 256 + p;
    return 7168 + (t2 - 16) * 256 + p;
}
__device__ __forceinline__ void wconv_phase(const Params& P, int li, unsigned char* lds, int it_lo, int it_hi, int widx, int wcount) {
    const int tid = threadIdx.x, lane = tid & 63, wave = tid >> 6;
    float* scr = (float*)(lds + wave * 16384);
    const int gw = widx * 8 + wave, NGW = wcount * 8;
    bf16_t* Win_t = (bf16_t*)(P.ws + W_IN); bf16_t* Wpa_t = (bf16_t*)(P.ws + W_PA); bf16_t* Wpc_t = (bf16_t*)(P.ws + W_PC); bf16_t* Wo_t = (bf16_t*)(P.ws + W_O);
    bf16_t* Wgu_t = (bf16_t*)(P.ws + W_GU); bf16_t* Wd_t = (bf16_t*)(P.ws + W_D);
    constexpr int I_A = 16 * 256, I_B = 16 * 32, I_C2 = 16 * 176, I_D = 44 * 32, NIT = I_A + 3 * I_B + I_C2 + I_D;
    (void)NIT;
    for (int it = it_lo + gw; it < it_hi; it += NGW) {
        int r = it;
        if (r < I_A) { const int kb = r >> 8, nb = r & 255; tr_item(P.in[I_WIN] + (size_t)li * DM * NIN, NIN, kb * 64, map_in(nb * 32), Win_t, DM, nb * 32, scr, lane); continue; } r -= I_A;
        if (r < I_B) { const int kb = r >> 5, nb = r & 31; tr_item(P.in[I_WPA] + (size_t)li * DM * DM, DM, kb * 64, nb * 32, Wpa_t, DM, nb * 32, scr, lane); continue; } r -= I_B;
        if (r < I_B) { const int kb = r >> 5, nb = r & 31; tr_item(P.in[I_WPC] + (size_t)li * DM * DM, DM, kb * 64, nb * 32, Wpc_t, DM, nb * 32, scr, lane); continue; } r -= I_B;
        if (r < I_B) { const int kb = r >> 5, nb = r & 31; tr_item(P.in[I_WO] + (size_t)li * DM * DM, DM, kb * 64, nb * 32, Wo_t, DM, nb * 32, scr, lane); continue; } r -= I_B;
        if (r < I_C2) { const int kb = r / 176, nb = r % 176, n0 = nb * 32, t = n0 >> 8, p = n0 & 255, bj = p >> 7, off = p & 127;
            tr_item((bj ? P.in[I_WU] : P.in[I_WG]) + (size_t)li * DM * DFF, DFF, kb * 64, t * 128 + off, Wgu_t, DM, n0, scr, lane); continue; } r -= I_C2;
        { const int kb = r >> 5, nb = r & 31; tr_item(P.in[I_WD] + (size_t)li * DFF * DM, DM, kb * 64, nb * 32, Wd_t, DFF, nb * 32, scr, lane); }
    }
}

__device__ __forceinline__ void prologue_phase(const Params& P, unsigned char* lds) {
    const int tid = threadIdx.x, lane = tid & 63, wave = tid >> 6;
    float* modv = (float*)(P.ws + WS_MOD); float* ctlf = (float*)(P.ws + WS_CTL);
    {
        float* sl = (float*)lds; float* red = sl + 3072;
        for (int i = tid; i < 3072; i += 512) { const float v = i < 2048 ? P.in[I_C][i] : P.in[I_CCTX][i - 2048]; sl[i] = v / (1.0f + expf(-v)); }
        __syncthreads();
        for (int chunk = blockIdx.x; chunk < 192; chunk += gridDim.x) {
            const int li = chunk / 96, colbase = (chunk % 96) * 64, kg = tid >> 6, cl = tid & 63;
            const float* w = P.in[I_WADA] + ((size_t)li * DM + kg * 128) * 6144 + colbase + cl;
            float a0 = 0.f, a1 = 0.f, a2 = 0.f;
#pragma unroll 8
            for (int kk = 0; kk < 128; ++kk) { const float wv = w[(size_t)kk * 6144]; const int k = kg * 128 + kk; a0 += sl[k] * wv; a1 += sl[1024 + k] * wv; a2 += sl[2048 + k] * wv; }
            red[(kg * 64 + cl) * 3 + 0] = a0; red[(kg * 64 + cl) * 3 + 1] = a1; red[(kg * 64 + cl) * 3 + 2] = a2;
            __syncthreads();
            if (tid < 192) { const int col = tid & 63, s = tid >> 6; float sum = P.in[I_BADA][li * 6144 + colbase + col];
#pragma unroll
                for (int g = 0; g < 8; ++g) sum += red[(g * 64 + col) * 3 + s];
                modv[(size_t)(li * 3 + s) * 6144 + colbase + col] = sum; }
            __syncthreads();
        }
    }
    {
        float* rope = (float*)(P.ws + WS_ROPE);
        for (int e = blockIdx.x * 512 + tid; e < SEQ * 32; e += gridDim.x * 512) {
            const int pos = e >> 5, i = e & 31, pp = i < 16 ? (pos >> 6) : (pos & 63), f = i & 15;
            const float inv = exp2f(-(float)f * 0.8304820237218406f);
            const float ang = (float)pp * inv;
            const double a = (double)ang, kq = __builtin_rint(a * 0.6366197723675814);
            const double r = __builtin_fma(-kq, 6.123233995736766e-17, __builtin_fma(-kq, 1.5707963267948966, a));
            const int q = (int)kq & 3;
            const double r2 = r * r;
            const double s = r * (1.0 + r2 * (-1.0 / 6 + r2 * (1.0 / 120 + r2 * (-1.0 / 5040 + r2 * (1.0 / 362880 + r2 * (-1.0 / 39916800))))));
            const double c = 1.0 + r2 * (-0.5 + r2 * (1.0 / 24 + r2 * (-1.0 / 720 + r2 * (1.0 / 40320 + r2 * (-1.0 / 3628800 + r2 * (1.0 / 479001600))))));
            double co, si;
            if (q == 0) { co = c; si = s; } else if (q == 1) { co = -s; si = c; } else if (q == 2) { co = -c; si = -s; } else { co = s; si = -c; }
            rope[(size_t)e * 2] = (float)co; rope[(size_t)e * 2 + 1] = (float)si;
        }
    }
    if (blockIdx.x == 0 && wave == 0) {
        for (int li = 0; li < 2; ++li) {
            float a = P.in[I_LQ1][li * 64 + lane] * P.in[I_LK1][li * 64 + lane], b = P.in[I_LQ2][li * 64 + lane] * P.in[I_LK2][li * 64 + lane];
            a = wave_sum(a); b = wave_sum(b);
            if (lane == 0) ctlf[li] = expf(a) - expf(b) + lam_init_of(li);
        }
    }
    __syncthreads();
    wconv_phase(P, 0, lds, 0, 4096, blockIdx.x, gridDim.x);
}

__device__ __forceinline__ void norm_phase(const Params& P, int li, int which, int Mrows, const float* XL, const float* XC, const float* part = nullptr, const float* pgate = nullptr, float* xc_out = nullptr) {
    const int tid = threadIdx.x, lane = tid & 63, wave = tid >> 6;
    const int gw = blockIdx.x * 8 + wave, NGW = gridDim.x * 8;
    const float* g = P.in[which ? I_N2G : I_N1G] + li * DM;
    const float* modv = (const float*)(P.ws + WS_MOD);
    bf16_t* H = (bf16_t*)(P.ws + WS_H);
    for (int row = gw; row < Mrows; row += NGW) {
        const int s = row < SEQ ? 0 : (row < NLAT ? 1 : 2);
        const float* xr = row < NLAT ? XL + (size_t)row * DM : XC + (size_t)(row - NLAT) * DM;
        const float* sh = modv + (size_t)(li * 3 + s) * 6144 + (which ? 3 : 0) * DM; const float* sc = sh + DM;
        const f32x4* x4 = (const f32x4*)xr + lane;
        f32x4 v[4]; float ss = 0.f;
#pragma unroll
        for (int j = 0; j < 4; ++j) v[j] = x4[64 * j];
        if (part && row >= NLAT) {
            const f32x4* p4 = (const f32x4*)(part + (size_t)(row - NLAT) * DM) + lane; f32x4* xo = (f32x4*)(xc_out + (size_t)(row - NLAT) * DM) + lane;
#pragma unroll
            for (int j = 0; j < 4; ++j) { const f32x4 sum = (p4[64 * j] + p4[64 * j + 512 * DM / 4]) + (p4[64 * j + 2 * 512 * DM / 4] + p4[64 * j + 3 * 512 * DM / 4]);
                v[j] = v[j] + ((const f32x4*)pgate)[lane + 64 * j] * sum; xo[64 * j] = v[j]; }
        }
#pragma unroll
        for (int j = 0; j < 4; ++j) ss += (v[j].x * v[j].x + v[j].y * v[j].y) + (v[j].z * v[j].z + v[j].w * v[j].w);
        const float rstd = rsqrtf(wave_sum(ss) * (1.0f / DM) + EPS);
        unsigned long long* o8 = (unsigned long long*)(H + (size_t)row * DM) + lane;
#pragma unroll
        for (int j = 0; j < 4; ++j) { const int c4 = lane + 64 * j; const f32x4 gg = ((const f32x4*)g)[c4], s4 = ((const f32x4*)sc)[c4], h4 = ((const f32x4*)sh)[c4];
            const f32x4 y = v[j] * rstd * gg * (1.0f + s4) + h4;
            o8[64 * j] = (unsigned long long)pk2(y.x, y.y) | ((unsigned long long)pk2(y.z, y.w) << 32); }
    }
}

__device__ __forceinline__ void conv_phase(const Params& P, int li, int Mrows, int widx, int wcount) {
    const bf16_t* U = (const bf16_t*)(P.ws + WS_R); bf16_t* CB = (bf16_t*)(P.ws + WS_R + SEC);
    const float* cw = P.in[I_CONVW] + (size_t)li * 3 * DM;
    const int total = Mrows * 128;
    for (int it = widx * 512 + threadIdx.x; it < total; it += wcount * 512) {
        const int row = it >> 7, c8 = (it & 127) * 8;
        int t, last; if (row < NLAT) { t = row & (SEQ - 1); last = SEQ - 1; } else { t = (row - NLAT) & (NCTX - 1); last = NCTX - 1; }
        const size_t off = (size_t)row * DM + c8;
        const u32x4v zero = {0u, 0u, 0u, 0u};
        const u32x4v u0 = *(const u32x4v*)(U + off), um = t > 0 ? *(const u32x4v*)(U + off - DM) : zero, up = t < last ? *(const u32x4v*)(U + off + DM) : zero, cb = *(const u32x4v*)(CB + off);
        f32x4 a0, a1, m0, m1, p0, p1, b0, b1; pg8::unpack8(u0, a0, a1); pg8::unpack8(um, m0, m1); pg8::unpack8(up, p0, p1); pg8::unpack8(cb, b0, b1);
        const f32x4 w00 = *(const f32x4*)(cw + c8), w01 = *(const f32x4*)(cw + c8 + 4), w10 = *(const f32x4*)(cw + DM + c8), w11 = *(const f32x4*)(cw + DM + c8 + 4), w20 = *(const f32x4*)(cw + 2 * DM + c8), w21 = *(const f32x4*)(cw + 2 * DM + c8 + 4);
        const f32x4 y0 = b0 * (m0 * w00 + a0 * w10 + p0 * w20), y1 = b1 * (m1 * w01 + a1 * w11 + p1 * w21);
        *(u32x4v*)(CB + off) = pg8::pack8(y0, y1);
    }
}

__device__ __forceinline__ void attn_phase(const Params& P, int li, unsigned char* lds) {
    const bf16_t* Q = (const bf16_t*)(P.ws + WS_R); const bf16_t* K = Q + SECE; const bf16_t* V = K + SECE; bf16_t* O = (bf16_t*)(P.ws + WS_ATT);
    const float lam = ((const float*)(P.ws + WS_CTL))[li]; const float oscale = 1.0f - lam_init_of(li); const float* subg = P.in[I_SUBG] + li * 128;
    const int G = gridDim.x, blk = blockIdx.x;
    const int xcd = blk & 7, slot = blk >> 3;
    const int nlat = (G == 256) ? 4 : (blk < 1024 ? (1024 - blk + G - 1) / G : 0);
    const int nctx = (li == 0 && blk < 32) ? (32 - blk + G - 1) / G : 0;
#define UNIT_PARAMS(i_, b_, h_, rowL_, nTL_, NT_, q0_) do { \
        if ((i_) < nlat) { int bh_, qb_; if (G == 256) { bh_ = xcd + 8 * ((i_) >> 1); qb_ = slot + 32 * ((i_) & 1); } else { const int u_ = blk + (i_) * G; bh_ = u_ >> 6; qb_ = u_ & 63; } \
            b_ = bh_ >> 3; h_ = bh_ & 7; q0_ = (size_t)b_ * SEQ + qb_ * 128; rowL_ = b_ * SEQ; nTL_ = 128; NT_ = 132; } \
        else { const int u_ = blk + ((i_) - nlat) * G, bh_ = u_ >> 1, qb_ = u_ & 1; b_ = bh_ >> 3; h_ = bh_ & 7; q0_ = (size_t)NLAT + b_ * NCTX + qb_ * 128; rowL_ = 0; nTL_ = 0; NT_ = 4; } } while (0)
    for (int i = 0; i < nlat + nctx; ++i) {
        int b, h, rowL, nTL, NT; size_t q0;
        UNIT_PARAMS(i, b, h, rowL, nTL, NT, q0);
        long nrow0 = -1; const bf16_t* nK = K; const bf16_t* nV = V;
        if (i + 1 < nlat + nctx) { int b2, h2, rowL2, nTL2, NT2; size_t q02; UNIT_PARAMS(i + 1, b2, h2, rowL2, nTL2, NT2, q02); (void)NT2; (void)q02;
            nK = K + h2 * 128; nV = V + h2 * 128; nrow0 = nTL2 > 0 ? (long)rowL2 : (long)(NLAT + b2 * NCTX); }
        att::attn_unit(Q + q0 * DM + h * 128, K + h * 128, V + h * 128, O + q0 * DM + h * 128, rowL, nTL, NLAT + b * NCTX, NT, lam, subg, oscale, (char*)lds, i > 0, nK, nV, nrow0);
    }
#undef UNIT_PARAMS
}

#define IN(k) (lo <= (k) && (k) < hi)
#ifndef SYNC_REP
#define SYNC_REP 1
#endif
#define SEAM(k) do { if (IN(k) && IN((k) + 1)) { for (int sr_ = 0; sr_ < SYNC_REP; ++sr_) xcd_barrier(bar); } } while (0)
#define TS(k) (TSUB < 0 || TSUB == (k))
#ifndef REP_ATT
#define REP_ATT 1
#endif
#ifndef REP_G
#define REP_G 1
#endif
#if REP_G == 2
#define GDUP(...) __VA_ARGS__ __VA_ARGS__
#else
#define GDUP(...) __VA_ARGS__
#endif
#ifndef REP_EW
#define REP_EW 1
#endif
template <int LI> __device__ __forceinline__ void layer_phases(const Params& P, unsigned char* lds, const int lo, const int hi, const XcdBarrier& bar) {
    constexpr int li = LI, B0 = 1 + 10 * LI;
    constexpr int Mr = (LI == 0) ? MT : NLAT;
    PG8_LAS unsigned char* lds3 = (PG8_LAS unsigned char*)lds;
    const int G = gridDim.x, c = blockIdx.x;
    if (IN(B0 + 0) && TS(0)) { if (LI == 1) { wconv_phase(P, 1, lds, 8448, 9856, blockIdx.x, gridDim.x); } for (int rep = 0; rep < REP_EW; ++rep) norm_phase(P, li, 0, MT, LI == 0 ? P.in[I_X] : P.out, LI == 0 ? P.in[I_CTX] : (const float*)(P.ws + WS_CTXX), LI == 1 ? (const float*)(P.ws + WS_PART) : nullptr, (const float*)(P.ws + WS_MOD) + (size_t)2 * 6144 + 5 * DM, (float*)(P.ws + WS_CTXX)); }
    SEAM(B0 + 0);
    if (IN(B0 + 1) && TS(1)) { GDUP({ pg8::Gemm g{(bf16_t*)(P.ws + WS_H), (bf16_t*)(P.ws + W_IN), MT, 3072, DM}; pg8::StaticOrder S; S.init(MT, 3072, G, c);
        pg8::EpiQKV E{(bf16_t*)(P.ws + WS_R), P.in[I_QNG] + li * 64, P.in[I_KNG] + li * 64, (const float*)(P.ws + WS_ROPE)};
        pg8::gemm_phase<pg8::EpiQKV, pg8::StaticOrder, true, true>(lds3, g, S, E);
        if (LI == 0 && (G <= 24 || c >= 24)) { __syncthreads(); wconv_phase(P, 0, lds, 4096, 9856, G > 24 ? c - 24 : c, G > 24 ? G - 24 : G); } }) }
    SEAM(B0 + 1);
    if (IN(B0 + 2) && TS(2)) { for (int rep = 0; rep < REP_ATT; ++rep) attn_phase(P, li, lds); }
    SEAM(B0 + 2);
    if (IN(B0 + 3) && TS(3)) { GDUP({ pg8::Gemm g{(bf16_t*)(P.ws + WS_H), (bf16_t*)(P.ws + W_IN) + (size_t)3072 * DM, Mr, 5120, DM}; pg8::StaticOrder S; S.init(Mr, 5120, G, c);
        pg8::EpiG2 E{(bf16_t*)(P.ws + WS_R)}; pg8::gemm_phase<pg8::EpiG2, pg8::StaticOrder, true, true>(lds3, g, S, E); }) }
    SEAM(B0 + 3);
    if (IN(B0 + 4) && TS(4)) {
        if (LI == 0 && G > 8) {
            if (c < 8) { bf16_t* R = (bf16_t*)(P.ws + WS_R); pg8::Gemm g{(bf16_t*)(P.ws + WS_ATT), (bf16_t*)(P.ws + W_PA), MT, DM, DM}; pg8::OneUnit S{64 + (c >> 2), c & 3, DM / 64, 1}; pg8::EpiM1 E{R + 2 * SECE};
                pg8::gemm_phase<pg8::EpiM1, pg8::OneUnit, true, true>(lds3, g, S, E); }
            else conv_phase(P, li, Mr, c - 8, G - 8);
        } else conv_phase(P, li, Mr, c, G);
    }
    SEAM(B0 + 4);
    if (IN(B0 + 5) && TS(5)) {
        bf16_t* R = (bf16_t*)(P.ws + WS_R);
        const bool early = (LI == 0 && G > 8);
        { pg8::Gemm g{(bf16_t*)(P.ws + WS_ATT), (bf16_t*)(P.ws + W_PA), Mr, DM, DM}; pg8::StaticOrder S; S.init(early ? NLAT : Mr, DM, G, c); pg8::EpiM1 E{R + 2 * SECE};
          pg8::gemm_phase<pg8::EpiM1, pg8::StaticOrder, true, true>(lds3, g, S, E); }
        { pg8::Gemm g{R + SECE, (bf16_t*)(P.ws + W_PC), Mr, DM, DM}; pg8::EpiM2 E{R + 2 * SECE, R + 3 * SECE};
          if (early) { pg8::SplitOrder S; S.init(NLAT, DM, G, c, DM, 1); pg8::gemm_phase<pg8::EpiM2, pg8::SplitOrder, true, true>(lds3, g, S, E); }
          else { pg8::StaticOrder S; S.init(Mr, DM, G, c); pg8::gemm_phase<pg8::EpiM2, pg8::StaticOrder, true, true>(lds3, g, S, E); } } }
    SEAM(B0 + 5);
    if (IN(B0 + 6) && TS(6)) { bf16_t* R = (bf16_t*)(P.ws + WS_R); float* ctxX = (float*)(P.ws + WS_CTXX);
        pg8::Gemm g{R + 3 * SECE, (bf16_t*)(P.ws + W_O), Mr, DM, DM};
        pg8::EpiRes E{LI == 0 ? P.in[I_X] : P.out, LI == 0 ? P.in[I_CTX] : ctxX, P.out, ctxX, (const float*)(P.ws + WS_MOD) + (size_t)li * 3 * 6144 + 2 * DM, LI == 0 ? (float*)(P.ws + WS_PART) : nullptr};
        if (LI == 0) { pg8::SplitOrder S; S.init(NLAT, DM, G, c, DM); pg8::gemm_phase<pg8::EpiRes, pg8::SplitOrder, true, true>(lds3, g, S, E); }
        else { pg8::StaticOrder S; S.init(Mr, DM, G, c); pg8::gemm_phase<pg8::EpiRes, pg8::StaticOrder, true, true>(lds3, g, S, E); }
        if (LI == 0 && (G <= 32 || c >= 32)) { __syncthreads(); wconv_phase(P, 1, lds, 0, 5120, G > 32 ? c - 32 : c, G > 32 ? G - 32 : G); } }
    SEAM(B0 + 6);
    if (IN(B0 + 7) && TS(7)) for (int rep = 0; rep < REP_EW; ++rep) norm_phase(P, li, 1, Mr, P.out, LI == 0 ? P.in[I_CTX] : (const float*)(P.ws + WS_CTXX), LI == 0 ? (const float*)(P.ws + WS_PART) : nullptr, (const float*)(P.ws + WS_MOD) + (size_t)2 * 6144 + 2 * DM, (float*)(P.ws + WS_CTXX));
    SEAM(B0 + 7);
    if (IN(B0 + 8) && TS(8)) { GDUP({ pg8::Gemm g{(bf16_t*)(P.ws + WS_H), (bf16_t*)(P.ws + W_GU), Mr, 2 * DFF, DM}; pg8::StaticOrder S; S.init(Mr, 2 * DFF, G, c);
        pg8::EpiGU E{(bf16_t*)(P.ws + WS_R)}; pg8::gemm_phase<pg8::EpiGU, pg8::StaticOrder, true, true>(lds3, g, S, E); }) }
    SEAM(B0 + 8);
    if (IN(B0 + 9) && TS(9)) { float* ctxX = (float*)(P.ws + WS_CTXX); pg8::Gemm g{(bf16_t*)(P.ws + WS_R), (bf16_t*)(P.ws + W_D), Mr, DM, DFF};
        pg8::EpiRes E{P.out, ctxX, P.out, ctxX, (const float*)(P.ws + WS_MOD) + (size_t)li * 3 * 6144 + 5 * DM, LI == 0 ? (float*)(P.ws + WS_PART) : nullptr};
        if (LI == 0) { pg8::SplitOrder S; S.init(NLAT, DM, G, c, DFF); pg8::gemm_phase<pg8::EpiRes, pg8::SplitOrder, true, true>(lds3, g, S, E); }
        else { pg8::StaticOrder S; S.init(Mr, DM, G, c, DFF); pg8::gemm_phase<pg8::EpiRes, pg8::StaticOrder, true, true>(lds3, g, S, E); }
        if (LI == 0 && (G <= 32 || c >= 32)) { __syncthreads(); wconv_phase(P, 1, lds, 5120, 8448, G > 32 ? c - 32 : c, G > 32 ? G - 32 : G); } }
    SEAM(B0 + 9);
}
__global__ void __launch_bounds__(512, 2) mk_fwd(Params P) {
    extern __shared__ __attribute__((aligned(16))) unsigned char lds[];
    const int lo = P.ph_lo, hi = P.ph_hi;
    if (lo < 0) cg::this_grid().sync();
    volatile LAS unsigned* st = (volatile LAS unsigned*)((LAS unsigned char*)lds + LDS_ST_OFF);
    if (threadIdx.x < 2) st[threadIdx.x] = 0u;
    __syncthreads();
    XcdBarrier bar = xcd_barrier_post((unsigned*)(P.ws + WS_CTL) + CW_BAR, st);
#ifndef PRO_REP
#define PRO_REP 1
#endif
    if (IN(0) && TS(10)) { for (int rep = 0; rep < PRO_REP; ++rep) { prologue_phase(P, lds); __syncthreads(); } }
    SEAM(0);
    layer_phases<0>(P, lds, lo, hi, bar);
    layer_phases<1>(P, lds, lo, hi, bar);
}
#undef IN
#undef SEAM
#undef TS

extern "C" void kernel_launch(void* const* d_in, const int* in_sizes, int n_in, void* d_out, int out_size, void* d_ws, size_t ws_size, hipStream_t stream) {
    static int grid = 0;
    if (grid == 0) {
        if (n_in != 23 || in_sizes[0] != NLAT * DM || out_size != NLAT * DM || ws_size < WS_END2) {
            fprintf(stderr, "kernel_launch: shape mismatch (n_in %d, in0 %d, out %d, ws %zu, need ws >= %zu)\n", n_in, n_in > 0 ? in_sizes[0] : -1, out_size, ws_size, (size_t)WS_END2); grid = -1; return; }
        int dev = 0, cus = 0, per_cu = 0;
        if (hipGetDevice(&dev) != hipSuccess || hipDeviceGetAttribute(&cus, hipDeviceAttributeMultiprocessorCount, dev) != hipSuccess) { fprintf(stderr, "kernel_launch: device query failed\n"); grid = -1; return; }
        if (hipFuncSetAttribute((const void*)mk_fwd, hipFuncAttributeMaxDynamicSharedMemorySize, LDS_BYTES) != hipSuccess) { fprintf(stderr, "kernel_launch: hipFuncSetAttribute failed\n"); grid = -1; return; }
        if (hipOccupancyMaxActiveBlocksPerMultiprocessor(&per_cu, (const void*)mk_fwd, 512, LDS_BYTES) != hipSuccess || per_cu < 1) { fprintf(stderr, "kernel_launch: occupancy query gave %d\n", per_cu); per_cu = 1; }
        (void)hipGetLastError();
        grid = cus * per_cu;
    }
    if (grid < 0) return;
    if (hipMemsetAsync((char*)d_ws + WS_CTL + CW_BAR * 4, 0, 16384, stream) != hipSuccess) { fprintf(stderr, "kernel_launch: memset failed\n"); return; }
    Params p{};
    for (int i = 0; i < 23; ++i) p.in[i] = (const float*)d_in[i];
    p.out = (float*)d_out; p.ws = (unsigned char*)d_ws;
#if MK_MULTI
    for (int ph = 0; ph < NPH; ++ph) { p.ph_lo = ph; p.ph_hi = ph + 1; hipLaunchKernelGGL(mk_fwd, dim3(grid), dim3(512), LDS_BYTES, stream, p); }
#else
    p.ph_lo = 0; p.ph_hi = NPH;
    void* args[] = {&p};
    hipError_t e = hipLaunchCooperativeKernel((const void*)mk_fwd, dim3(grid), dim3(512), args, LDS_BYTES, stream);
    if (e != hipSuccess) fprintf(stderr, "kernel_launch: cooperative launch failed: %s (grid %d)\n", hipGetErrorString(e), grid);
#endif
}
```
